# Optimizing an MI355X kernel written in HIP

```python
import math
import jax, jax.numpy as jnp
from jax import lax
import numpy as np

D_MODEL = 1024
BATCH = 8
SEQ = 8192
DEPTH = 1

HEAD_DIM = 64
SWA_Q_HEADS = 8
SWA_KV_HEADS = 2
SWA_GROUP = SWA_Q_HEADS // SWA_KV_HEADS
SWA_WINDOW = 128
SB_HEADS = 8
BLOCK = 128
REL_BUCKETS = 32
REL_MAX_DIST = 128
D_FF = 2816
N_BRANCH = 2
RMS_EPS = 1e-6
NEG_BIG = -1e30

SWA_Q_W = SWA_Q_HEADS * HEAD_DIM
SWA_KV_W = SWA_KV_HEADS * HEAD_DIM
SB_W = SB_HEADS * HEAD_DIM
IN_SIZES = (SWA_Q_W, SWA_KV_W, SWA_KV_W, SB_W, SB_W, SB_W, D_MODEL, D_MODEL)
IN_W = sum(IN_SIZES)
IN_SPLITS = tuple(int(v) for v in np.cumsum(IN_SIZES)[:-1])

kernel_name = 'hybrid_swa_sink_stickbreaking_macaron'


def rmsnorm(x, g):
    xf = x.astype(jnp.float32)
    y = xf * lax.rsqrt(jnp.mean(xf * xf, axis=-1, keepdims=True) + RMS_EPS) * g.astype(jnp.float32)
    return y.astype(x.dtype)


def swiglu(h, w1, w3, w2):
    return (jax.nn.silu(h @ w1) * (h @ w3)) @ w2


def rel_bucket(dist):
    max_exact = REL_BUCKETS // 2
    d = jnp.maximum(dist, 1).astype(jnp.float32)
    large = max_exact + (jnp.log(d / max_exact) / math.log(REL_MAX_DIST / max_exact)
                         * (REL_BUCKETS - max_exact)).astype(jnp.int32)
    large = jnp.minimum(large, REL_BUCKETS - 1)
    return jnp.where(dist < max_exact, dist, large)


def sliding_window_attention(q, k, v, sinks, rel_table):
    B, S = q.shape[0], q.shape[1]
    nb = S // BLOCK
    qb = q.astype(jnp.float32).reshape(B, nb, BLOCK, SWA_KV_HEADS, SWA_GROUP, HEAD_DIM)
    kb = k.astype(jnp.float32).reshape(B, nb, BLOCK, SWA_KV_HEADS, HEAD_DIM)
    vb = v.astype(jnp.float32).reshape(B, nb, BLOCK, SWA_KV_HEADS, HEAD_DIM)
    pad = ((0, 0), (1, 0), (0, 0), (0, 0), (0, 0))
    kw = jnp.concatenate([jnp.pad(kb, pad)[:, :-1], kb], axis=2)
    vw = jnp.concatenate([jnp.pad(vb, pad)[:, :-1], vb], axis=2)
    logits = jnp.einsum('bnqhgd,bnkhd->bnhgqk', qb, kw) * (HEAD_DIM ** -0.5)
    qi = jnp.arange(BLOCK)[:, None] + BLOCK
    kj = jnp.arange(2 * BLOCK)[None, :]
    dist = qi - kj
    band = (dist >= 0) & (dist < SWA_WINDOW)
    bias = rel_table.astype(jnp.float32)[rel_bucket(jnp.maximum(dist, 0))]
    bias = bias.transpose(2, 0, 1).reshape(SWA_KV_HEADS, SWA_GROUP, BLOCK, 2 * BLOCK)
    key_pos = jnp.arange(nb)[:, None] * BLOCK + jnp.arange(2 * BLOCK)[None, :] - BLOCK
    valid = band[None] & (key_pos >= 0)[:, None, :]
    logits = jnp.where(valid[None, :, None, None], logits + bias, NEG_BIG)
    sink = sinks.astype(jnp.float32).reshape(SWA_KV_HEADS, SWA_GROUP)[None, None, :, :, None, None]
    m = jnp.maximum(jnp.max(logits, axis=-1, keepdims=True), sink)
    p = jnp.exp(logits - m)
    p = p / (jnp.sum(p, axis=-1, keepdims=True) + jnp.exp(sink - m))
    o = jnp.einsum('bnhgqk,bnkhd->bnqhgd', p, vw)
    return o.reshape(B, S, SWA_Q_W).astype(q.dtype)


def stick_breaking_attention(q, k, v):
    B, S = q.shape[0], q.shape[1]
    nb = S // BLOCK
    qf = q.astype(jnp.float32).transpose(0, 2, 1, 3) * (HEAD_DIM ** -0.5)
    kf = k.astype(jnp.float32).transpose(0, 2, 1, 3)
    vf = v.astype(jnp.float32).transpose(0, 2, 1, 3)
    qblocks = qf.reshape(B, SB_HEADS, nb, BLOCK, HEAD_DIM).transpose(2, 0, 1, 3, 4)
    key_pos = jnp.arange(S)

    def one_block(args):
        q_blk, start = args
        z = jnp.einsum('bhqd,bhkd->bhqk', q_blk, kf)
        q_pos = start + jnp.arange(BLOCK)
        causal = key_pos[None, :] < q_pos[:, None]
        log_keep = jnp.where(causal, jax.nn.log_sigmoid(-z), 0.0)
        rev = lax.cumsum(log_keep, axis=3, reverse=True)
        between = jnp.concatenate([rev[..., 1:], jnp.zeros_like(rev[..., :1])], axis=-1)
        a = jnp.where(causal, jnp.exp(jax.nn.log_sigmoid(z) + between), 0.0)
        return jnp.einsum('bhqk,bhkd->bhqd', a, vf)

    o = lax.map(one_block, (qblocks, jnp.arange(nb) * BLOCK))
    return o.transpose(1, 0, 3, 2, 4).reshape(B, S, SB_W).astype(q.dtype)


def setup_inputs(seed: int = 0) -> dict:
    key = jax.random.key(seed)
    ks = jax.random.split(key, 20)
    f32 = jnp.float32

    def w(k, shape, fan_in):
        return jax.random.normal(k, shape, f32) * (fan_in ** -0.5)

    def gain(k):
        return 1.0 + 0.02 * jax.random.normal(k, (DEPTH, D_MODEL), f32)

    return {
        'x': jax.random.normal(ks[0], (BATCH, SEQ, D_MODEL), f32),
        'norm_ffn1': gain(ks[1]),
        'ffn1_w1': w(ks[2], (DEPTH, D_MODEL, D_FF), D_MODEL),
        'ffn1_w3': w(ks[3], (DEPTH, D_MODEL, D_FF), D_MODEL),
        'ffn1_w2': w(ks[4], (DEPTH, D_FF, D_MODEL), D_FF),
        'norm_mix': gain(ks[5]),
        'w_in': w(ks[6], (DEPTH, D_MODEL, IN_W), D_MODEL),
        'swa_sinks': 0.5 * jax.random.normal(ks[7], (DEPTH, SWA_Q_HEADS), f32),
        'rel_bias': 0.5 * jax.random.normal(ks[8], (REL_BUCKETS, SWA_Q_HEADS), f32),
        'w_branch_swa': w(ks[9], (DEPTH, SWA_Q_W, D_MODEL), SWA_Q_W),
        'w_branch_sb': w(ks[10], (DEPTH, SB_W, D_MODEL), SB_W),
        'w_out': w(ks[11], (DEPTH, D_MODEL, D_MODEL), D_MODEL),
        'norm_ffn2': gain(ks[12]),
        'ffn2_w1': w(ks[13], (DEPTH, D_MODEL, D_FF), D_MODEL),
        'ffn2_w3': w(ks[14], (DEPTH, D_MODEL, D_FF), D_MODEL),
        'ffn2_w2': w(ks[15], (DEPTH, D_FF, D_MODEL), D_FF),
        'norm_final': 1.0 + 0.02 * jax.random.normal(ks[16], (D_MODEL,), f32),
    }


def reference(x, norm_ffn1, ffn1_w1, ffn1_w3, ffn1_w2, norm_mix, w_in, swa_sinks, rel_bias,
              w_branch_swa, w_branch_sb, w_out, norm_ffn2, ffn2_w1, ffn2_w3, ffn2_w2, norm_final):
    B, S = x.shape[0], x.shape[1]
    for layer in range(DEPTH):
        h = rmsnorm(x, norm_ffn1[layer])
        x = x + 0.5 * swiglu(h, ffn1_w1[layer], ffn1_w3[layer], ffn1_w2[layer])
        h = rmsnorm(x, norm_mix[layer])
        proj = h @ w_in[layer]
        q_a, k_a, v_a, q_b, k_b, v_b, g_a, g_b = jnp.split(proj, IN_SPLITS, axis=-1)
        o_a = sliding_window_attention(
            q_a.reshape(B, S, SWA_Q_HEADS, HEAD_DIM),
            k_a.reshape(B, S, SWA_KV_HEADS, HEAD_DIM),
            v_a.reshape(B, S, SWA_KV_HEADS, HEAD_DIM),
            swa_sinks[layer], rel_bias)
        o_b = stick_breaking_attention(
            q_b.reshape(B, S, SB_HEADS, HEAD_DIM),
            k_b.reshape(B, S, SB_HEADS, HEAD_DIM),
            v_b.reshape(B, S, SB_HEADS, HEAD_DIM))
        merged = (jax.nn.sigmoid(g_a) * (o_a @ w_branch_swa[layer])
                  + jax.nn.sigmoid(g_b) * (o_b @ w_branch_sb[layer]))
        x = x + merged @ w_out[layer]
        h = rmsnorm(x, norm_ffn2[layer])
        x = x + 0.5 * swiglu(h, ffn2_w1[layer], ffn2_w3[layer], ffn2_w2[layer])
    return rmsnorm(x, norm_final)
```

```cpp
#include <hip/hip_runtime.h>
#include <hip/hip_cooperative_groups.h>
#include <cstdio>
#include <cstdint>
namespace cg = cooperative_groups;

#define LAS __attribute__((address_space(3)))
typedef unsigned short bf16_t;
typedef short bf16x8 __attribute__((ext_vector_type(8)));
typedef float f32x4 __attribute__((ext_vector_type(4)));
typedef unsigned u32x4 __attribute__((ext_vector_type(4)));
typedef unsigned u32x2 __attribute__((ext_vector_type(2)));
typedef float f32x2 __attribute__((ext_vector_type(2)));

constexpr int D_MODEL = 1024, BATCH = 8, SEQ = 8192, M_TOK = BATCH * SEQ, D_FF = 2816, IN_W = 4352;
constexpr float RMS_EPS = 1e-6f;
constexpr int U_PITCH = 2880;
constexpr size_t U_SLAB = (size_t)SEQ * IN_W;
constexpr int PITCH = IN_W;
constexpr int C_QA = 0, C_KA = 512, C_VA = 640, C_QB = 768, C_KB = 1280, C_VB = 1792, C_GA = 2304, C_GB = 3328;

__device__ __forceinline__ unsigned cvt_pk_bf16(float lo, float hi) { unsigned r; asm volatile("v_cvt_pk_bf16_f32 %0, %1, %2" : "=v"(r) : "v"(lo), "v"(hi)); return r; }
__device__ __forceinline__ float bf_lo(unsigned w) { return __uint_as_float(w << 16); }
__device__ __forceinline__ float bf_hi(unsigned w) { return __uint_as_float(w & 0xffff0000u); }
__device__ __forceinline__ float fast_rcp(float x) { return __builtin_amdgcn_rcpf(x); }
__device__ __forceinline__ float fast_exp(float x) { return __builtin_amdgcn_exp2f(x * 1.44269504089f); }
__device__ __forceinline__ float fast_log(float x) { return __builtin_amdgcn_logf(x) * 0.69314718056f; }
__device__ __forceinline__ float sigmoidf_(float v) { return fast_rcp(1.0f + fast_exp(-v)); }

namespace pg8 {
constexpr int BM = 256, BK = 64, HALF = 128, HTB = HALF * BK * 2, STAGE_BYTES = 8 * HTB, NXCD = 8, WGM = 8;
__host__ __device__ __forceinline__ int lds_byte(int r, int c) { const int st = (r >> 4) * 2 + (c >> 5), rr = r & 15, cc = c & 31, ob = rr * 64 + cc * 2; return st * 1024 + (ob ^ (((ob >> 9) & 1) << 5)); }
__host__ __device__ __forceinline__ void stage_rc(int b, int& R, int& C) { const int st = b / 1024, sb = b % 1024, swz = sb ^ (((sb >> 9) & 1) << 5); R = (st >> 1) * 16 + swz / 64; C = (st & 1) * 32 + (swz % 64) / 2; }
__host__ __device__ __forceinline__ int perm32(int rho) { const int n = rho >> 4, i = rho & 15; return 8 * (i >> 2) + 4 * n + (i & 3); }

#ifndef RB
#define RB 4
#endif
struct Unit { int pm, pn; };
struct Gemm { const bf16_t* A; const bf16_t* Bt; int M, N, K, lda; size_t aslab = 0; };

struct StaticOrder {
    int nM, nN, nwg, G, c, rev;
    __device__ void init(int M, int N, int G_, int c_, int rev_ = 0) { nM = M / BM; nN = N / BM; nwg = nM * nN; G = G_; c = c_; rev = rev_; }
    __device__ bool next(int i, Unit& u) const {
        if ((long)i * G + c >= nwg) return false;
        const long L = (long)(rev ? (nwg / G - 1 - i) : i) * G + c;
        int wgid = (int)L; { const int q = nwg / NXCD, r = nwg % NXCD, xcd = wgid % NXCD, off = wgid / NXCD; wgid = (xcd < r ? xcd * (q + 1) : r * (q + 1) + (xcd - r) * q) + off; }
        const int nig = WGM * nN, gid = wgid / nig, fm = gid * WGM, gsz = (nM - fm) < WGM ? (nM - fm) : WGM;
        u.pm = fm + ((wgid % nig) % gsz); u.pn = (wgid % nig) / gsz; return true;
    }
};

template <int NP> __device__ __forceinline__ void load_rs(const float* ssp, int row0, int fq, float (&rs)[2][4]) {
    if (NP == 1) {
#pragma unroll
        for (int ai = 0; ai < 2; ++ai)
#pragma unroll
            for (int m = 0; m < 4; ++m) rs[ai][m] = ssp[row0 + ai * HALF + m * 16];
    } else {
        f32x4 p[2][4];
#pragma unroll
        for (int ai = 0; ai < 2; ++ai)
#pragma unroll
            for (int m = 0; m < 4; ++m) p[ai][m] = *(const f32x4*)(ssp + (size_t)(row0 + ai * HALF + m * 16) * 16 + 4 * fq);
#pragma unroll
        for (int ai = 0; ai < 2; ++ai)
#pragma unroll
            for (int m = 0; m < 4; ++m) { float s = (p[ai][m][0] + p[ai][m][1]) + (p[ai][m][2] + p[ai][m][3]); s += __shfl_xor(s, 16); s += __shfl_xor(s, 32); rs[ai][m] = s; }
    }
#pragma unroll
    for (int ai = 0; ai < 2; ++ai)
#pragma unroll
        for (int m = 0; m < 4; ++m) rs[ai][m] = __builtin_amdgcn_rsqf(rs[ai][m] * (1.0f / D_MODEL) + RMS_EPS);
}

template <int NP> struct EpiSwiglu {
    static constexpr bool PERM = true;
    bf16_t* U; const float* ssp;
    __device__ __forceinline__ void operator()(const f32x4 (&acc)[2][2][4][2], const Unit& u, int wr, int wc, int fr, int fq) const {
        const int row0 = u.pm * BM + wr * 64 + fr, col0 = u.pn * HALF + wc * 32 + 8 * fq;
        float rs[2][4]; load_rs<NP>(ssp, row0, fq, rs);
#pragma unroll
        for (int ai = 0; ai < 2; ++ai)
#pragma unroll
            for (int m = 0; m < 4; ++m) {
                const int row = row0 + ai * HALF + m * 16; const float r = rs[ai][m];
                const float nrl = r * -1.44269504089f, r2 = r * r;
                unsigned pk[4];
#pragma unroll
                for (int q = 0; q < 4; ++q) {
                    const f32x4 ga = acc[ai][0][m][q >> 1], ua = acc[ai][1][m][q >> 1]; const int e0 = 2 * (q & 1);
                    const f32x2 g = (f32x2){ga[e0], ga[e0 + 1]}, up = (f32x2){ua[e0], ua[e0 + 1]};
                    const f32x2 t = g * nrl; f32x2 ex; ex.x = __builtin_amdgcn_exp2f(t.x); ex.y = __builtin_amdgcn_exp2f(t.y);
                    const f32x2 d = ex + 1.0f; f32x2 rc; rc.x = __builtin_amdgcn_rcpf(d.x); rc.y = __builtin_amdgcn_rcpf(d.y);
                    const f32x2 o = (g * up) * (rc * r2);
                    pk[q] = cvt_pk_bf16(o.x, o.y);
                }
                u32x4 w; w.x = pk[0]; w.y = pk[1]; w.z = pk[2]; w.w = pk[3];
                *(u32x4*)(U + (size_t)(row >> 13) * U_SLAB + (size_t)(row & (SEQ - 1)) * U_PITCH + col0) = w;
            }
    }
};
struct EpiProj {
    static constexpr bool PERM = true;
    bf16_t* P; const float* ssp;
    template <bool GATE> __device__ __forceinline__ void body(const f32x4 (&acc)[2][2][4][2], const Unit& u, int wr, int wc, int fr, int fq) const {
        const int row0 = u.pm * BM + wr * 64 + fr, col0 = u.pn * BM + wc * 32 + 8 * fq;
        float rs[2][4]; load_rs<16>(ssp, row0, fq, rs);
#pragma unroll
        for (int ai = 0; ai < 2; ++ai)
#pragma unroll
            for (int m = 0; m < 4; ++m) {
                const int row = row0 + ai * HALF + m * 16; const float r = rs[ai][m], nrl = r * -1.44269504089f;
#pragma unroll
                for (int bj = 0; bj < 2; ++bj) {
                    unsigned pk[4];
#pragma unroll
                    for (int q = 0; q < 4; ++q) {
                        const f32x4 va = acc[ai][bj][m][q >> 1]; const int e0 = 2 * (q & 1);
                        const f32x2 v = (f32x2){va[e0], va[e0 + 1]};
                        f32x2 o;
                        if (GATE) { const f32x2 t = v * nrl; f32x2 ex; ex.x = __builtin_amdgcn_exp2f(t.x); ex.y = __builtin_amdgcn_exp2f(t.y);
                            const f32x2 d = ex + 1.0f; o.x = __builtin_amdgcn_rcpf(d.x); o.y = __builtin_amdgcn_rcpf(d.y); }
                        else o = v * r;
                        pk[q] = cvt_pk_bf16(o.x, o.y);
                    }
                    u32x4 w; w.x = pk[0]; w.y = pk[1]; w.z = pk[2]; w.w = pk[3];
                    *(u32x4*)(P + (size_t)row * PITCH + col0 + bj * HALF) = w;
                }
            }
    }
    __device__ __forceinline__ void operator()(const f32x4 (&acc)[2][2][4][2], const Unit& u, int wr, int wc, int fr, int fq) const {
        if (u.pn >= 9) body<true>(acc, u, wr, wc, fr, fq); else body<false>(acc, u, wr, wc, fr, fq);
    }
};
template <bool ADD> struct EpiGate {
    static constexpr bool PERM = true;
    const bf16_t* SG; bf16_t* MO;
    __device__ __forceinline__ void operator()(const f32x4 (&acc)[2][2][4][2], const Unit& u, int wr, int wc, int fr, int fq) const {
        const int row0 = u.pm * BM + wr * 64 + fr, col0 = u.pn * BM + wc * 32 + 8 * fq;
#pragma unroll
        for (int ai = 0; ai < 2; ++ai) {
            u32x4 sg[4][2], pr[4][2];
#pragma unroll
            for (int m = 0; m < 4; ++m)
#pragma unroll
                for (int bj = 0; bj < 2; ++bj) { const size_t roff = (size_t)(row0 + ai * HALF + m * 16) * PITCH + col0 + bj * HALF;
                    sg[m][bj] = *(const u32x4*)(SG + roff); if (ADD) pr[m][bj] = *(const u32x4*)(MO + roff); else pr[m][bj] = (u32x4){0u, 0u, 0u, 0u}; }
            asm volatile("" ::: "memory");
#pragma unroll
            for (int m = 0; m < 4; ++m)
#pragma unroll
                for (int bj = 0; bj < 2; ++bj) {
                    const size_t roff = (size_t)(row0 + ai * HALF + m * 16) * PITCH + col0 + bj * HALF;
                    float o[8];
#pragma unroll
                    for (int q = 0; q < 4; ++q) {
                        const f32x4 a = acc[ai][bj][m][q >> 1]; const int e = 2 * (q & 1);
                        o[2 * q] = bf_lo(sg[m][bj][q]) * a[e] + (ADD ? bf_lo(pr[m][bj][q]) : 0.f);
                        o[2 * q + 1] = bf_hi(sg[m][bj][q]) * a[e + 1] + (ADD ? bf_hi(pr[m][bj][q]) : 0.f);
                    }
                    u32x4 w; w.x = cvt_pk_bf16(o[0], o[1]); w.y = cvt_pk_bf16(o[2], o[3]); w.z = cvt_pk_bf16(o[4], o[5]); w.w = cvt_pk_bf16(o[6], o[7]);
                    *(u32x4*)(MO + roff) = w;
                }
        }
    }
};
template <bool BASE_F32, bool OUT_F32> struct EpiResid {
    static constexpr bool PERM = true;
    const float* basef; float* out; bf16_t* xb; float* ssp; float alpha;
    __device__ __forceinline__ void operator()(const f32x4 (&acc)[2][2][4][2], const Unit& u, int wr, int wc, int fr, int fq) const {
        const int row0 = u.pm * BM + wr * 64 + fr, col0 = u.pn * BM + wc * 32 + 8 * fq;
#pragma unroll
        for (int ai = 0; ai < 2; ++ai)
#pragma unroll
        for (int mh = 0; mh < 4; mh += RB) {
            f32x4 bf[BASE_F32 ? RB : 1][2][2]; u32x4 bb[BASE_F32 ? 1 : RB][2];
#pragma unroll
            for (int mm = 0; mm < RB; ++mm) { const size_t off = (size_t)(row0 + ai * HALF + (mh + mm) * 16) * D_MODEL + col0;
#pragma unroll
                for (int bj = 0; bj < 2; ++bj) {
                    if (BASE_F32) { bf[mm][bj][0] = *(const f32x4*)(basef + off + bj * HALF); bf[mm][bj][1] = *(const f32x4*)(basef + off + bj * HALF + 4); }
                    else bb[mm][bj] = *(const u32x4*)(xb + off + bj * HALF);
                } }
            asm volatile("" ::: "memory");
#pragma unroll
            for (int mm = 0; mm < RB; ++mm) {
                const int m = mh + mm;
                const int row = row0 + ai * HALF + m * 16; const size_t off = (size_t)row * D_MODEL + col0; float s = 0.f;
#pragma unroll
                for (int bj = 0; bj < 2; ++bj) {
                    f32x4 b0, b1;
                    if (BASE_F32) { b0 = bf[mm][bj][0]; b1 = bf[mm][bj][1]; }
                    else { const u32x4 w = bb[mm][bj]; b0 = (f32x4){bf_lo(w.x), bf_hi(w.x), bf_lo(w.y), bf_hi(w.y)}; b1 = (f32x4){bf_lo(w.z), bf_hi(w.z), bf_lo(w.w), bf_hi(w.w)}; }
                    const f32x4 o0 = b0 + acc[ai][bj][m][0] * alpha, o1 = b1 + acc[ai][bj][m][1] * alpha;
                    if (OUT_F32) { *(f32x4*)(out + off + bj * HALF) = o0; *(f32x4*)(out + off + bj * HALF + 4) = o1; }
                    else { u32x4 w; w.x = cvt_pk_bf16(o0[0], o0[1]); w.y = cvt_pk_bf16(o0[2], o0[3]); w.z = cvt_pk_bf16(o1[0], o1[1]); w.w = cvt_pk_bf16(o1[2], o1[3]); *(u32x4*)(xb + off + bj * HALF) = w; }
                    s += ((o0[0] * o0[0] + o0[1] * o0[1]) + (o0[2] * o0[2] + o0[3] * o0[3])) + ((o1[0] * o1[0] + o1[1] * o1[1]) + (o1[2] * o1[2] + o1[3] * o1[3]));
                }
                if (ssp) { s += __shfl_xor(s, 16); s += __shfl_xor(s, 32); if (fq == 0) ssp[(size_t)row * 16 + u.pn * 4 + wc] = s; }
            }
            asm volatile("" ::: "memory");
        }
    }
};

struct EpiFinalLocal {
    static constexpr bool PERM = true;
    const bf16_t* xb; float* out; float* ssp; unsigned* cnt; const float* gain; float alpha;
    __device__ __forceinline__ void operator()(const f32x4 (&acc)[2][2][4][2], const Unit& u, int wr, int wc, int fr, int fq) const {
        const int row0 = u.pm * BM + wr * 64 + fr, col0 = u.pn * BM + wc * 32 + 8 * fq;
        f32x4 o[2][4][2][2];
#pragma unroll
        for (int ai = 0; ai < 2; ++ai) {
            u32x4 bb[4][2];
#pragma unroll
            for (int m = 0; m < 4; ++m)
#pragma unroll
                for (int bj = 0; bj < 2; ++bj) bb[m][bj] = *(const u32x4*)(xb + (size_t)(row0 + ai * HALF + m * 16) * D_MODEL + col0 + bj * HALF);
#pragma unroll
            for (int m = 0; m < 4; ++m) { float s = 0.f;
#pragma unroll
                for (int bj = 0; bj < 2; ++bj) { const u32x4 w = bb[m][bj];
                    const f32x4 o0 = (f32x4){bf_lo(w.x), bf_hi(w.x), bf_lo(w.y), bf_hi(w.y)} + acc[ai][bj][m][0] * alpha, o1 = (f32x4){bf_lo(w.z), bf_hi(w.z), bf_lo(w.w), bf_hi(w.w)} + acc[ai][bj][m][1] * alpha;
                    o[ai][m][bj][0] = o0; o[ai][m][bj][1] = o1;
                    s += ((o0[0] * o0[0] + o0[1] * o0[1]) + (o0[2] * o0[2] + o0[3] * o0[3])) + ((o1[0] * o1[0] + o1[1] * o1[1]) + (o1[2] * o1[2] + o1[3] * o1[3])); }
                s += __shfl_xor(s, 16); s += __shfl_xor(s, 32);
                if (fq == 0) ssp[(size_t)(row0 + ai * HALF + m * 16) * 16 + u.pn * 4 + wc] = s; }
        }
        asm volatile("s_waitcnt vmcnt(0)" ::: "memory");
        __builtin_amdgcn_s_barrier();
        if (__builtin_amdgcn_readfirstlane(threadIdx.x >> 6) == 0) {
            if ((threadIdx.x & 63) == 0) {
                unsigned* c = cnt + 64 * u.pm;
                (void)__hip_atomic_fetch_add(c, 1u, __ATOMIC_RELAXED, __HIP_MEMORY_SCOPE_AGENT);
                unsigned sp = 0;
                while (__hip_atomic_load(c, __ATOMIC_RELAXED, __HIP_MEMORY_SCOPE_AGENT) < 4u) { __builtin_amdgcn_s_sleep(1); if (++sp > (1u << 22)) break; }
                __builtin_amdgcn_fence(__ATOMIC_ACQUIRE, "agent");
            }
            asm volatile("s_waitcnt vmcnt(0)" ::: "memory");
        }
        __builtin_amdgcn_s_barrier(); asm volatile("" ::: "memory");
        float rs[2][4];
        { f32x4 p[2][4];
#pragma unroll
          for (int ai = 0; ai < 2; ++ai)
#pragma unroll
            for (int m = 0; m < 4; ++m) p[ai][m] = *(const volatile f32x4*)(ssp + (size_t)(row0 + ai * HALF + m * 16) * 16 + 4 * fq);
#pragma unroll
          for (int ai = 0; ai < 2; ++ai)
#pragma unroll
            for (int m = 0; m < 4; ++m) { float s = (p[ai][m][0] + p[ai][m][1]) + (p[ai][m][2] + p[ai][m][3]); s += __shfl_xor(s, 16); s += __shfl_xor(s, 32); rs[ai][m] = __builtin_amdgcn_rsqf(s * (1.0f / D_MODEL) + RMS_EPS); } }
        f32x4 gv[2][2];
#pragma unroll
        for (int bj = 0; bj < 2; ++bj) { gv[bj][0] = *(const f32x4*)(gain + col0 + bj * HALF); gv[bj][1] = *(const f32x4*)(gain + col0 + bj * HALF + 4); }
#pragma unroll
        for (int ai = 0; ai < 2; ++ai)
#pragma unroll
            for (int m = 0; m < 4; ++m) { const size_t off = (size_t)(row0 + ai * HALF + m * 16) * D_MODEL + col0; const float r = rs[ai][m];
#pragma unroll
                for (int bj = 0; bj < 2; ++bj) { *(f32x4*)(out + off + bj * HALF) = o[ai][m][bj][0] * r * gv[bj][0]; *(f32x4*)(out + off + bj * HALF + 4) = o[ai][m][bj][1] * r * gv[bj][1]; } }
    }
};

template <class Epi>
__device__ __forceinline__ void gemm_phase(LAS unsigned char* lds, const Gemm g, const StaticOrder& S, const Epi& E) {
    int tid = threadIdx.x; asm volatile("" : "+v"(tid));
    const int wid = __builtin_amdgcn_readfirstlane(tid >> 6), lane = tid & 63, wr = wid >> 2, wc = wid & 3, fr = lane & 15, fq = lane >> 4;
    const int K = g.K, nt = K / BK, lda = g.lda;
    unsigned voffA[2], voffB[2];
#pragma unroll
    for (int i = 0; i < 2; ++i) { int R, C; stage_rc(tid * 16 + i * 8192, R, C); const int Rb = Epi::PERM ? ((R & ~31) + perm32(R & 31)) : R;
        voffA[i] = (unsigned)(R * lda + C) * 2u; voffB[i] = (unsigned)(Rb * K + C) * 2u; }
    const size_t kstep = (size_t)(BK * 2);
    const size_t hstepA = (size_t)HALF * lda * 2, hstepB = (size_t)HALF * K * 2;
    const size_t tstepA = 2 * hstepA, tstepB = 2 * hstepB;
    const unsigned ldsw = (unsigned)wid * 1024u;
    const int aoff = lds_byte(wr * 64 + fr, fq * 8), boff = lds_byte(wc * 32 + fr, fq * 8);
#define PG8_SA(b, h) (((b) * 2 + (h)) * HTB)
#define PG8_SB(b, h) ((4 + (b) * 2 + (h)) * HTB)
#define PG8_STAGE(bufoff, gbase, voff) do { _Pragma("unroll") for (int _i = 0; _i < 2; ++_i) \
        __builtin_amdgcn_global_load_lds((const unsigned*)((const char*)(gbase) + (voff)[_i]), (LAS unsigned*)(lds + (bufoff) + ldsw + _i * 8192), 16, 0, 0); } while (0)
#define PG8_LDA(dst, b, h) do { _Pragma("unroll") for (int m = 0; m < 4; ++m) _Pragma("unroll") for (int k = 0; k < 2; ++k) dst[m][k] = *(const LAS bf16x8*)(lds + PG8_SA(b, h) + aoff + m * 2048 + k * 1024); } while (0)
#define PG8_LDB(dst, b, h) do { _Pragma("unroll") for (int n = 0; n < 2; ++n) _Pragma("unroll") for (int k = 0; k < 2; ++k) dst[n][k] = *(const LAS bf16x8*)(lds + PG8_SB(b, h) + boff + n * 2048 + k * 1024); } while (0)
#define PG8_MMA(ai, bj, At, Bt) do { __builtin_amdgcn_s_setprio(1); _Pragma("unroll") for (int m = 0; m < 4; ++m) _Pragma("unroll") for (int n = 0; n < 2; ++n) _Pragma("unroll") for (int k = 0; k < 2; ++k) \
        acc[ai][bj][m][n] = __builtin_amdgcn_mfma_f32_16x16x32_bf16(Bt[n][k], At[m][k], acc[ai][bj][m][n], 0, 0, 0); __builtin_amdgcn_s_setprio(0); } while (0)
#define PG8_WAIT_V(n) asm volatile("s_waitcnt vmcnt(" #n ")" ::: "memory")
#define PG8_WAIT_L(n) asm volatile("s_waitcnt lgkmcnt(" #n ")" ::: "memory")
#define PG8_BAR __builtin_amdgcn_s_barrier()
#define PG8_SCHED __builtin_amdgcn_sched_barrier(0)
    Unit cur, nxt; int ui = 0;
    if (!S.next(0, cur)) return;
    f32x4 acc[2][2][4][2];
#pragma unroll
    for (int a = 0; a < 2; ++a)
#pragma unroll
        for (int b = 0; b < 2; ++b)
#pragma unroll
            for (int m = 0; m < 4; ++m)
#pragma unroll
                for (int n = 0; n < 2; ++n) acc[a][b][m][n] = (f32x4){0.f, 0.f, 0.f, 0.f};
    bf16x8 At[4][2], B0[2][2], B1[2][2];
    const size_t aslab = g.aslab ? g.aslab : 32 * tstepA;
    const char* cA = (const char*)g.A + (size_t)(cur.pm >> 5) * aslab + (size_t)(cur.pm & 31) * tstepA; const char* cB = (const char*)g.Bt + (size_t)cur.pn * tstepB;
    PG8_STAGE(PG8_SB(0, 0), cB, voffB); PG8_STAGE(PG8_SB(0, 1), cB + hstepB, voffB); PG8_STAGE(PG8_SA(0, 0), cA, voffA); PG8_STAGE(PG8_SA(0, 1), cA + hstepA, voffA);
    if (wr == 1) PG8_BAR;
    PG8_WAIT_V(2); PG8_BAR;
    PG8_STAGE(PG8_SB(1, 0), cB + kstep, voffB); PG8_STAGE(PG8_SA(1, 0), cA + kstep, voffA); PG8_STAGE(PG8_SB(1, 1), cB + hstepB + kstep, voffB);
    PG8_WAIT_V(6); PG8_BAR;
    for (;;) {
        const bool has_next = S.next(ui + 1, nxt);
        const char* nA = has_next ? (const char*)g.A + (size_t)(nxt.pm >> 5) * aslab + (size_t)(nxt.pm & 31) * tstepA : cA; const char* nB = has_next ? (const char*)g.Bt + (size_t)nxt.pn * tstepB : cB;
        for (int t = 0; t < nt; t += 2) {
            const bool last = (t == nt - 2);
            const char* a1 = cA + (size_t)(t + 1) * kstep;
            const char* a2 = last ? nA : cA + (size_t)(t + 2) * kstep; const char* b2 = last ? nB : cB + (size_t)(t + 2) * kstep;
            const char* a3 = a2 + kstep; const char* b3 = b2 + kstep;
            PG8_LDB(B0, 0, 0); PG8_LDB(B1, 0, 1); PG8_SCHED; PG8_LDA(At, 0, 0); PG8_STAGE(PG8_SA(1, 1), a1 + hstepA, voffA);
            PG8_WAIT_V(8); PG8_WAIT_L(0); PG8_BAR; PG8_MMA(0, 0, At, B0); PG8_MMA(0, 1, At, B1); PG8_BAR; PG8_SCHED;
            PG8_LDA(At, 0, 1); PG8_STAGE(PG8_SB(0, 0), b2, voffB); PG8_STAGE(PG8_SB(0, 1), b2 + hstepB, voffB); PG8_STAGE(PG8_SA(0, 0), a2, voffA);
            PG8_WAIT_V(8); PG8_WAIT_L(0); PG8_BAR; PG8_MMA(1, 0, At, B0); PG8_MMA(1, 1, At, B1); PG8_BAR; PG8_SCHED;
            PG8_LDB(B0, 1, 0); PG8_LDB(B1, 1, 1); PG8_SCHED; PG8_LDA(At, 1, 0); PG8_STAGE(PG8_SA(0, 1), a2 + hstepA, voffA);
            PG8_WAIT_V(8); PG8_WAIT_L(0); PG8_BAR; PG8_MMA(0, 0, At, B0); PG8_MMA(0, 1, At, B1); PG8_BAR; PG8_SCHED;
            PG8_LDA(At, 1, 1); PG8_STAGE(PG8_SB(1, 0), b3, voffB); PG8_STAGE(PG8_SB(1, 1), b3 + hstepB, voffB); PG8_STAGE(PG8_SA(1, 0), a3, voffA);
            PG8_WAIT_V(8); PG8_WAIT_L(0); PG8_BAR; PG8_MMA(1, 0, At, B0); PG8_MMA(1, 1, At, B1); PG8_BAR; PG8_SCHED;
        }
        if (wr == 0) PG8_BAR;
        E(acc, cur, wr, wc, fr, fq);
        if (!has_next) break;
#pragma unroll
        for (int a = 0; a < 2; ++a)
#pragma unroll
            for (int b = 0; b < 2; ++b)
#pragma unroll
                for (int m = 0; m < 4; ++m)
#pragma unroll
                    for (int n = 0; n < 2; ++n) acc[a][b][m][n] = (f32x4){0.f, 0.f, 0.f, 0.f};
        cur = nxt; cA = nA; cB = nB; ++ui;
        if (wr == 1) PG8_BAR;
    }
    PG8_WAIT_V(0);
    PG8_BAR;
#undef PG8_SA
#undef PG8_SB
#undef PG8_STAGE
#undef PG8_LDA
#undef PG8_LDB
#undef PG8_MMA
#undef PG8_WAIT_V
#undef PG8_WAIT_L
#undef PG8_BAR
#undef PG8_SCHED
}
}

__device__ __forceinline__ int kpos(int key) { return (key & ~31) | (((key >> 2) & 3) << 3) | (((key >> 4) & 1) << 2) | (key & 3); }
__device__ __forceinline__ f32x4 mfma16(bf16x8 a, bf16x8 b, f32x4 c) { return __builtin_amdgcn_mfma_f32_16x16x32_bf16(a, b, c, 0, 0, 0); }
__device__ __forceinline__ int t5_bucket(int d) {
    if (d < 16) return d;
    int b = 16;
    b += d >= 19; b += d >= 21; b += d >= 24; b += d >= 27; b += d >= 31; b += d >= 35; b += d >= 40; b += d >= 46;
    b += d >= 52; b += d >= 59; b += d >= 67; b += d >= 77; b += d >= 87; b += d >= 99; b += d >= 113;
    return b;
}

constexpr int AP = 80;
__device__ __forceinline__ void tr16(unsigned addr, u32x2 (&v)[16]) {
    asm volatile(
        "ds_read_b64_tr_b16 %0, %16 offset:0\n\tds_read_b64_tr_b16 %1, %16 offset:2560\n\tds_read_b64_tr_b16 %2, %16 offset:32\n\tds_read_b64_tr_b16 %3, %16 offset:2592\n\t"
        "ds_read_b64_tr_b16 %4, %16 offset:64\n\tds_read_b64_tr_b16 %5, %16 offset:2624\n\tds_read_b64_tr_b16 %6, %16 offset:96\n\tds_read_b64_tr_b16 %7, %16 offset:2656\n\t"
        "ds_read_b64_tr_b16 %8, %16 offset:5120\n\tds_read_b64_tr_b16 %9, %16 offset:7680\n\tds_read_b64_tr_b16 %10, %16 offset:5152\n\tds_read_b64_tr_b16 %11, %16 offset:7712\n\t"
        "ds_read_b64_tr_b16 %12, %16 offset:5184\n\tds_read_b64_tr_b16 %13, %16 offset:7744\n\tds_read_b64_tr_b16 %14, %16 offset:5216\n\tds_read_b64_tr_b16 %15, %16 offset:7776\n\t"
        "s_waitcnt lgkmcnt(0)"
        : "=&v"(v[0]), "=&v"(v[1]), "=&v"(v[2]), "=&v"(v[3]), "=&v"(v[4]), "=&v"(v[5]), "=&v"(v[6]), "=&v"(v[7]),
          "=&v"(v[8]), "=&v"(v[9]), "=&v"(v[10]), "=&v"(v[11]), "=&v"(v[12]), "=&v"(v[13]), "=&v"(v[14]), "=&v"(v[15])
        : "v"(addr) : "memory");
}
__device__ __forceinline__ bf16x8 vfrag(const u32x2 (&v)[16], int jj, int dt) {
    u32x4 w; w.x = v[(jj * 4 + dt) * 2].x; w.y = v[(jj * 4 + dt) * 2].y; w.z = v[(jj * 4 + dt) * 2 + 1].x; w.w = v[(jj * 4 + dt) * 2 + 1].y; return __builtin_bit_cast(bf16x8, w);
}
__device__ __forceinline__ bf16x8 pfrag(const float (&a)[4][4], int jj) {
    u32x4 pw; pw.x = cvt_pk_bf16(a[2 * jj][0], a[2 * jj][1]); pw.y = cvt_pk_bf16(a[2 * jj][2], a[2 * jj][3]);
    pw.z = cvt_pk_bf16(a[2 * jj + 1][0], a[2 * jj + 1][1]); pw.w = cvt_pk_bf16(a[2 * jj + 1][2], a[2 * jj + 1][3]); return __builtin_bit_cast(bf16x8, pw);
}

__device__ __forceinline__ void tr8(unsigned addr, u32x2 (&v)[8]) {
    asm volatile(
        "ds_read_b64_tr_b16 %0, %8 offset:0\n\tds_read_b64_tr_b16 %1, %8 offset:2560\n\tds_read_b64_tr_b16 %2, %8 offset:32\n\tds_read_b64_tr_b16 %3, %8 offset:2592\n\t"
        "ds_read_b64_tr_b16 %4, %8 offset:64\n\tds_read_b64_tr_b16 %5, %8 offset:2624\n\tds_read_b64_tr_b16 %6, %8 offset:96\n\tds_read_b64_tr_b16 %7, %8 offset:2656\n\t"
        "s_waitcnt lgkmcnt(0)"
        : "=&v"(v[0]), "=&v"(v[1]), "=&v"(v[2]), "=&v"(v[3]), "=&v"(v[4]), "=&v"(v[5]), "=&v"(v[6]), "=&v"(v[7])
        : "v"(addr) : "memory");
}
constexpr int SWA_V_OFF = 256 * AP * 2, SWA_BT_OFF = SWA_V_OFF + 272 * AP * 2;
struct SwaUnit { int hk, n, b; };
__device__ __forceinline__ SwaUnit swa_unit(int ui) { SwaUnit u; u.hk = ui & 1; u.n = (ui >> 1) & 63; u.b = ui >> 7; return u; }
__device__ __forceinline__ void swa_fetch(const bf16_t* P, const SwaUnit& u, int tid, u32x4 (&kr)[4], u32x4 (&vr)[4]) {
    const size_t tokp = (size_t)u.b * SEQ + 128 * u.n - 128;
#pragma unroll
    for (int i = 0; i < 4; ++i) {
        const int c = tid + 512 * i, key = c >> 3, dp = c & 7;
        kr[i] = (u32x4){0u, 0u, 0u, 0u}; vr[i] = (u32x4){0u, 0u, 0u, 0u};
        if (u.n > 0 || key >= 128) { const bf16_t* src = P + (tokp + key) * PITCH + C_KA + 64 * u.hk + 8 * dp; kr[i] = *(const u32x4*)src; vr[i] = *(const u32x4*)(src + (C_VA - C_KA)); }
    }
}
__device__ __forceinline__ int unit_remap(int ui, int G, int NU, int loc) { if (!loc) return ui; const int L = G >> 3, i = ui / G, c = ui - i * G; return (c / L) * (NU >> 3) + (c % L) + L * i; }
__device__ __forceinline__ void swa_phase(LAS unsigned char* lds, const bf16_t* P, bf16_t* OB, const float* sinks, const float* rel_bias, int G, int cu, int loc) {
    int tid = threadIdx.x; asm volatile("" : "+v"(tid));
    const int lane = tid & 63, w = __builtin_amdgcn_readfirstlane(tid >> 6), fr = lane & 15, fq = lane >> 4;
    LAS bf16_t* Ks = (LAS bf16_t*)lds; LAS bf16_t* Vs = (LAS bf16_t*)(lds + SWA_V_OFF); LAS float* bt = (LAS float*)(lds + SWA_BT_OFF);
    const unsigned vlane = (unsigned)(size_t)(lds + SWA_V_OFF) + (unsigned)((16 * w + 4 * fq + (fr >> 2)) * (AP * 2) + 8 * (fr & 3));
    for (int t = tid; t < 1024; t += 512) { const int h = t >> 7, d = t & 127; bt[t] = rel_bias[t5_bucket(d) * 8 + h]; }
    for (int t = tid; t < 16 * AP / 2; t += 512) ((LAS unsigned*)(Vs + 256 * AP))[t] = 0u;
    constexpr int NU = BATCH * 64 * 2;
    u32x4 kr[4], vr[4];
    if (cu < NU) swa_fetch(P, swa_unit(unit_remap(cu, G, NU, loc)), tid, kr, vr);
    const int qi = 16 * w + fr;
    for (int ui = cu; ui < NU; ui += G) {
        const SwaUnit u = swa_unit(unit_remap(ui, G, NU, loc));
        const size_t qtok = (size_t)u.b * SEQ + 128 * u.n + qi;
        const bf16_t* qp = P + qtok * PITCH + C_QA + 256 * u.hk + 8 * fq;
        bf16x8 q0n = *(const bf16x8*)qp, q1n = *(const bf16x8*)(qp + 32);
        __syncthreads();
#pragma unroll
        for (int i = 0; i < 4; ++i) { const int c = tid + 512 * i, key = c >> 3, dp = c & 7; *(LAS u32x4*)(Ks + key * AP + 8 * dp) = kr[i]; *(LAS u32x4*)(Vs + key * AP + 8 * dp) = vr[i]; }
        __syncthreads();
        if (ui + G < NU) swa_fetch(P, swa_unit(unit_remap(ui + G, G, NU, loc)), tid, kr, vr);
#pragma unroll 1
        for (int g = 0; g < 4; ++g) {
        const int h = 4 * u.hk + g;
        const bf16x8 q0 = q0n, q1 = q1n;
        if (g < 3) { q0n = *(const bf16x8*)(qp + 64 * (g + 1)); q1n = *(const bf16x8*)(qp + 64 * (g + 1) + 32); }
        const float sink = sinks[h];
        float bias[9][4];
#pragma unroll
        for (int j = 0; j < 9; ++j)
#pragma unroll
            for (int r = 0; r < 4; ++r) bias[j][r] = bt[h * 128 + ((128 + fr - 16 * j - 4 * fq - r) & 127)];
        f32x4 S[9];
#pragma unroll
        for (int j = 0; j < 9; ++j) {
            const LAS bf16_t* kp = Ks + (16 * w + 16 * j + fr) * AP + 8 * fq;
            f32x4 s = (f32x4){0.f, 0.f, 0.f, 0.f};
            s = mfma16(*(const LAS bf16x8*)kp, q0, s); s = mfma16(*(const LAS bf16x8*)(kp + 32), q1, s); S[j] = s;
        }
        float mx = sink;
#pragma unroll
        for (int j = 0; j < 9; ++j)
#pragma unroll
            for (int r = 0; r < 4; ++r) {
                float l = S[j][r] * 0.125f + bias[j][r];
                if (j == 0) l = (4 * fq + r > fr) ? l : -1e30f;
                if (j == 8) l = (4 * fq + r <= fr) ? l : -1e30f;
                S[j][r] = l;
            }
        if (u.n == 0) {
#pragma unroll
            for (int j = 0; j < 9; ++j)
#pragma unroll
                for (int r = 0; r < 4; ++r) S[j][r] = (16 * w + 16 * j + 4 * fq + r >= 128) ? S[j][r] : -1e30f;
        }
#pragma unroll
        for (int j = 0; j < 9; ++j) mx = fmaxf(mx, fmaxf(fmaxf(S[j][0], S[j][1]), fmaxf(S[j][2], S[j][3])));
        mx = fmaxf(mx, __shfl_xor(mx, 16)); mx = fmaxf(mx, __shfl_xor(mx, 32));
        const float mxl = mx * 1.44269504089f;
        float sum = 0.f;
        f32x4 O[4];
#pragma unroll
        for (int dt = 0; dt < 4; ++dt) O[dt] = (f32x4){0.f, 0.f, 0.f, 0.f};
#pragma unroll
        for (int cc = 0; cc < 2; ++cc) {
            u32x2 vf[16]; tr16(vlane + (unsigned)(cc * 64 * AP * 2), vf);
            float p[4][4];
#pragma unroll
            for (int j = 0; j < 4; ++j)
#pragma unroll
                for (int r = 0; r < 4; ++r) { p[j][r] = __builtin_amdgcn_exp2f(S[4 * cc + j][r] * 1.44269504089f - mxl); sum += p[j][r]; }
#pragma unroll
            for (int jj = 0; jj < 2; ++jj) { const bf16x8 pf = pfrag(p, jj);
#pragma unroll
                for (int dt = 0; dt < 4; ++dt) O[dt] = mfma16(vfrag(vf, jj, dt), pf, O[dt]); }
        }
        {
            u32x2 vf[8]; tr8(vlane + (unsigned)(128 * AP * 2), vf);
            float p[4];
#pragma unroll
            for (int r = 0; r < 4; ++r) { p[r] = __builtin_amdgcn_exp2f(S[8][r] * 1.44269504089f - mxl); sum += p[r]; }
            u32x4 pw; pw.x = cvt_pk_bf16(p[0], p[1]); pw.y = cvt_pk_bf16(p[2], p[3]); pw.z = 0u; pw.w = 0u;
            const bf16x8 pf = __builtin_bit_cast(bf16x8, pw);
#pragma unroll
            for (int dt = 0; dt < 4; ++dt) { u32x4 wv; wv.x = vf[dt * 2].x; wv.y = vf[dt * 2].y; wv.z = vf[dt * 2 + 1].x; wv.w = vf[dt * 2 + 1].y; O[dt] = mfma16(__builtin_bit_cast(bf16x8, wv), pf, O[dt]); }
        }
        sum += __shfl_xor(sum, 16); sum += __shfl_xor(sum, 32);
        const float inv = 1.0f / (sum + __builtin_amdgcn_exp2f(sink * 1.44269504089f - mxl));
        bf16_t* op = OB + qtok * D_MODEL + 64 * h + 4 * fq;
#pragma unroll
        for (int dt = 0; dt < 4; ++dt) { u32x2 wv; wv.x = cvt_pk_bf16(O[dt][0] * inv, O[dt][1] * inv); wv.y = cvt_pk_bf16(O[dt][2] * inv, O[dt][3] * inv); *(u32x2*)(op + 16 * dt) = wv; }
        }
    }
    __syncthreads();
}

constexpr int SB_PRE = 3, SB_TILES = SB_PRE + 2, SB_KEYS = 64 * SB_TILES, SB_NLD = SB_KEYS / 64;
constexpr int SB_V_OFF = SB_KEYS * AP * 2, SB_FLAG_OFF = 2 * SB_V_OFF;
constexpr float SB_DONE = 1e-30f;
struct SbUnit { int h, qt, b; };
__device__ __forceinline__ SbUnit sb_unit(int ui) { SbUnit u; u.h = ui & 7; u.qt = (ui >> 3) & 63; u.b = ui >> 9; return u; }
__device__ __forceinline__ void sb_fetch(const bf16_t* P, const SbUnit& u, int tid, u32x4 (&kr)[SB_NLD], u32x4 (&vr)[SB_NLD]) {
    const int k0 = 128 * u.qt - 64 * SB_PRE;
#pragma unroll
    for (int i = 0; i < SB_NLD; ++i) {
        const int c = tid + 512 * i, key = c >> 3, dp = c & 7;
        kr[i] = (u32x4){0u, 0u, 0u, 0u}; vr[i] = (u32x4){0u, 0u, 0u, 0u};
        if (k0 + key >= 0) { const bf16_t* src = P + ((size_t)u.b * SEQ + k0 + key) * PITCH + C_KB + 64 * u.h + 8 * dp; kr[i] = *(const u32x4*)src; vr[i] = *(const u32x4*)(src + (C_VB - C_KB)); }
    }
}
template <bool DIAG>
__device__ __forceinline__ void sb_step(const LAS bf16_t* Kt, unsigned vaddr, int kbase, int qpos, bf16x8 q0, bf16x8 q1, float& carry, f32x4 (&O)[4], int fr, int fq) {
    f32x4 s[2];
#pragma unroll
    for (int j = 0; j < 2; ++j) {
        const LAS bf16_t* kp = Kt + (16 * j + fr) * AP + 8 * fq;
        f32x4 t = (f32x4){0.f, 0.f, 0.f, 0.f};
        t = mfma16(*(const LAS bf16x8*)kp, q0, t); t = mfma16(*(const LAS bf16x8*)(kp + 32), q1, t); s[j] = t;
    }
    u32x2 vf[8]; tr8(vaddr, vf);
    f32x2 sg[4], om[4];
#pragma unroll
    for (int r = 0; r < 4; ++r) {
        f32x2 t = (f32x2){s[0][r], s[1][r]} * (-0.125f * 1.44269504089f);
        t.x = __builtin_amdgcn_fmed3f(t.x, -115.4f, 115.4f); t.y = __builtin_amdgcn_fmed3f(t.y, -115.4f, 115.4f);
        f32x2 ex; ex.x = __builtin_amdgcn_exp2f(t.x); ex.y = __builtin_amdgcn_exp2f(t.y);
        const f32x2 d = ex + 1.0f; f32x2 rc; rc.x = __builtin_amdgcn_rcpf(d.x); rc.y = __builtin_amdgcn_rcpf(d.y);
        f32x2 o = ex * rc;
        if (DIAG) { const int key = kbase + 4 * fq + r; const bool c0 = key < qpos, c1 = key + 16 < qpos;
            rc.x = c0 ? rc.x : 0.f; o.x = c0 ? o.x : 1.f; rc.y = c1 ? rc.y : 0.f; o.y = c1 ? o.y : 1.f; }
        sg[r] = rc; om[r] = o;
    }
    const f32x2 g = (om[0] * om[1]) * (om[2] * om[3]);
    f32x2 x1; x1.x = __shfl_xor(g.x, 16); x1.y = __shfl_xor(g.y, 16);
    const f32x2 p1 = g * x1;
    f32x2 x2; x2.x = __shfl_xor(p1.x, 32); x2.y = __shfl_xor(p1.y, 32);
    const f32x2 T = p1 * x2;
    const f32x2 one = (f32x2){1.0f, 1.0f};
    const f32x2 hi = fq == 0 ? (x1 * x2) : (fq == 1 ? x2 : (fq == 2 ? x1 : one));
    f32x2 accv; accv.y = carry * hi.y; accv.x = carry * T.y * hi.x;
    float a_[2][4];
#pragma unroll
    for (int r = 3; r >= 0; --r) { const f32x2 a = sg[r] * accv; accv = accv * om[r]; a_[0][r] = a.x; a_[1][r] = a.y; }
    carry = carry * T.y * T.x;
    u32x4 pw; pw.x = cvt_pk_bf16(a_[0][0], a_[0][1]); pw.y = cvt_pk_bf16(a_[0][2], a_[0][3]); pw.z = cvt_pk_bf16(a_[1][0], a_[1][1]); pw.w = cvt_pk_bf16(a_[1][2], a_[1][3]);
    const bf16x8 pf = __builtin_bit_cast(bf16x8, pw);
#pragma unroll
    for (int dt = 0; dt < 4; ++dt) { u32x4 wv; wv.x = vf[dt * 2].x; wv.y = vf[dt * 2].y; wv.z = vf[dt * 2 + 1].x; wv.w = vf[dt * 2 + 1].y; O[dt] = mfma16(__builtin_bit_cast(bf16x8, wv), pf, O[dt]); }
}
__device__ __forceinline__ void sb_phase(LAS unsigned char* lds, const bf16_t* P, bf16_t* OB, int G, int cu, int loc) {
    int tid = threadIdx.x; asm volatile("" : "+v"(tid));
    const int lane = tid & 63, w = __builtin_amdgcn_readfirstlane(tid >> 6), fr = lane & 15, fq = lane >> 4;
    LAS bf16_t* Ks = (LAS bf16_t*)lds; LAS bf16_t* Vs = (LAS bf16_t*)(lds + SB_V_OFF); volatile LAS int* flags = (volatile LAS int*)(lds + SB_FLAG_OFF);
    const unsigned vlane = (unsigned)(size_t)(lds + SB_V_OFF) + (unsigned)((4 * fq + (fr >> 2)) * (AP * 2) + 8 * (fr & 3));
    constexpr int NU = BATCH * 64 * 8;
    u32x4 kr[SB_NLD], vr[SB_NLD];
    bf16x8 q0n = (bf16x8){0, 0, 0, 0, 0, 0, 0, 0}, q1n = q0n;
    if (cu < NU) { const SbUnit u0 = sb_unit(unit_remap(cu, G, NU, loc)); sb_fetch(P, u0, tid, kr, vr);
        const bf16_t* qp0 = P + ((size_t)u0.b * SEQ + 128 * u0.qt + 16 * w + fr) * PITCH + C_QB + 64 * u0.h + 8 * fq; q0n = *(const bf16x8*)qp0; q1n = *(const bf16x8*)(qp0 + 32); }
    int fbit = 0;
    __syncthreads();
    for (int ui = cu; ui < NU; ui += G) {
        const SbUnit u = sb_unit(unit_remap(ui, G, NU, loc));
        const size_t tokb = (size_t)u.b * SEQ;
        const int qpos = 128 * u.qt + 16 * w + fr, qmax = 128 * u.qt + 16 * w + 15;
        const bf16x8 q0 = q0n, q1 = q1n;
#pragma unroll
        for (int i = 0; i < SB_NLD; ++i) { const int c = tid + 512 * i, key = c >> 3, dp = c & 7; *(LAS u32x4*)(Ks + key * AP + 8 * dp) = kr[i]; *(LAS u32x4*)(Vs + key * AP + 8 * dp) = vr[i]; }
        __syncthreads();
        if (ui + G < NU) { const SbUnit un = sb_unit(unit_remap(ui + G, G, NU, loc)); sb_fetch(P, un, tid, kr, vr);
            const bf16_t* qpn = P + ((size_t)un.b * SEQ + 128 * un.qt + 16 * w + fr) * PITCH + C_QB + 64 * un.h + 8 * fq; q0n = *(const bf16x8*)qpn; q1n = *(const bf16x8*)(qpn + 32); }
        float carry = 1.0f; bool done = false;
        f32x4 O[4];
#pragma unroll
        for (int dt = 0; dt < 4; ++dt) O[dt] = (f32x4){0.f, 0.f, 0.f, 0.f};
        const int kt0 = 2 * u.qt - SB_PRE, kt_lo = kt0 > 0 ? kt0 : 0;
        const int ks_diag = (128 * u.qt + 16 * w) >> 5;
#pragma unroll 1
        for (int ks = (qmax - 1) >> 5; ks >= 2 * kt_lo && !done; --ks) {
            const int row = 32 * ks - 64 * kt0;
            if (ks >= ks_diag) sb_step<true>(Ks + row * AP, vlane + (unsigned)(row * AP * 2), 32 * ks, qpos, q0, q1, carry, O, fr, fq);
            else sb_step<false>(Ks + row * AP, vlane + (unsigned)(row * AP * 2), 32 * ks, qpos, q0, q1, carry, O, fr, fq);
            done = __all(carry < SB_DONE) != 0;
        }
        if (lane == 0) flags[w] = (!done && kt_lo > 0) ? 1 : 0;
        __syncthreads();
        const int more = flags[0] | flags[1] | flags[2] | flags[3] | flags[4] | flags[5] | flags[6] | flags[7];
        if (more) {
#pragma unroll 1
            for (int kt = kt_lo - 1; kt >= 0; --kt) {
                volatile LAS int* fl = flags + 8 + 8 * fbit; fbit ^= 1;
                if (lane == 0) fl[w] = done ? 1 : 0;
                __syncthreads();
                const int all = fl[0] & fl[1] & fl[2] & fl[3] & fl[4] & fl[5] & fl[6] & fl[7];
                if (all) break;
                { const int key = tid >> 3, dp = tid & 7;
                  const bf16_t* src = P + (tokb + 64 * kt + key) * PITCH + C_KB + 64 * u.h + 8 * dp;
                  const u32x4 kv = *(const u32x4*)src, vv = *(const u32x4*)(src + (C_VB - C_KB));
                  *(LAS u32x4*)(Ks + key * AP + 8 * dp) = kv; *(LAS u32x4*)(Vs + key * AP + 8 * dp) = vv; }
                __syncthreads();
                if (!done) { sb_step<false>(Ks + 32 * AP, vlane + (unsigned)(32 * AP * 2), 64 * kt + 32, qpos, q0, q1, carry, O, fr, fq); done = __all(carry < SB_DONE) != 0; }
                if (!done) { sb_step<false>(Ks, vlane, 64 * kt, qpos, q0, q1, carry, O, fr, fq); done = __all(carry < SB_DONE) != 0; }
            }
            __syncthreads();
        }
        bf16_t* op = OB + (tokb + qpos) * D_MODEL + 512 + 64 * u.h + 4 * fq;
#pragma unroll
        for (int dt = 0; dt < 4; ++dt) { u32x2 wv; wv.x = cvt_pk_bf16(O[dt][0], O[dt][1]); wv.y = cvt_pk_bf16(O[dt][2], O[dt][3]); *(u32x2*)(op + 16 * dt) = wv; }
    }
    __syncthreads();
}

#define XB_TMO      128
#define XB_XCNT(j)  (256  + 64 * (j))
#define XB_XSUB(j)  (1280 + 64 * (j))
#define XB_XGEN(j)  (2304 + 64 * (j))
#define XB_TOP      3328
#define XB_TOPGEN   3392
#define XCD_BAR_WORDS 3456
#define XB_SPIN_CAP (1u << 20)
__device__ __forceinline__ unsigned xb_ld(unsigned* p)              { return __hip_atomic_load(p, __ATOMIC_RELAXED, __HIP_MEMORY_SCOPE_AGENT); }
__device__ __forceinline__ unsigned xb_add(unsigned* p, unsigned v) { return __hip_atomic_fetch_add(p, v, __ATOMIC_RELAXED, __HIP_MEMORY_SCOPE_AGENT); }
__device__ __forceinline__ unsigned xb_xcc_id() { return (unsigned)__builtin_amdgcn_s_getreg((3 << 11) | 20) & 0xFu; }
#define XB_SPIN(cond, bar) do { unsigned _sp = 0; while (cond) { __builtin_amdgcn_s_sleep(1); \
    if ((++_sp & 255u) == 0u) { if (xb_ld(&(bar)[XB_TMO])) break; if (_sp > XB_SPIN_CAP) { atomicAdd(&(bar)[XB_TMO], 1u); break; } } } } while (0)
struct XcdBarrier { unsigned* bar; unsigned x; volatile LAS unsigned* st; };
__device__ __forceinline__ XcdBarrier xcd_barrier_post(unsigned* bar, volatile LAS unsigned* st) {
    XcdBarrier b; b.bar = bar; b.x = xb_xcc_id(); b.st = st;
    if (threadIdx.x == 0) (void)xb_add(&bar[XB_XCNT(b.x)], 1u);
    return b;
}
__device__ __forceinline__ void xcd_barrier_complete(unsigned* bar, unsigned x, unsigned& nloc, unsigned& nx) {
    const unsigned G = gridDim.x * gridDim.y * gridDim.z;
    unsigned sum, cnt, mine, sp = 0u;
    for (;;) {
        sum = 0u; cnt = 0u; mine = 0u;
#pragma unroll
        for (unsigned j = 0; j < 16; ++j) { const unsigned c = xb_ld(&bar[XB_XCNT(j)]); sum += c; cnt += (c > 0u) ? 1u : 0u; mine = (j == x) ? c : mine; }
        if (sum == G) break;
        __builtin_amdgcn_s_sleep(1);
        if ((++sp & 255u) == 0u) { if (xb_ld(&bar[XB_TMO])) break; if (sp > XB_SPIN_CAP) { atomicAdd(&bar[XB_TMO], 1u); break; } }
    }
    nloc = mine > 0u ? mine : 1u; nx = cnt > 0u ? cnt : 1u;
}
__device__ __forceinline__ void xcd_barrier(const XcdBarrier& b) {
    asm volatile("s_waitcnt vmcnt(0)" ::: "memory");
    __syncthreads();
    if (threadIdx.x == 0) {
        unsigned* bar = b.bar;
        __builtin_amdgcn_s_waitcnt(0);
        unsigned nloc = b.st[0], nx = b.st[1];
        if (nloc == 0u) { xcd_barrier_complete(bar, b.x, nloc, nx); b.st[0] = nloc; b.st[1] = nx; }
        const unsigned old = xb_add(&bar[XB_XSUB(b.x)], 1u);
        const unsigned gen = old / nloc;
        if (old + 1u == (gen + 1u) * nloc) {
            __builtin_amdgcn_fence(__ATOMIC_RELEASE, "agent");
            asm volatile("s_waitcnt vmcnt(0)" ::: "memory");
            const unsigned og = xb_add(&bar[XB_TOP], 1u);
            const unsigned tg = og / nx;
            if (og + 1u == (tg + 1u) * nx) xb_add(&bar[XB_TOPGEN], 1u);
            else XB_SPIN(xb_ld(&bar[XB_TOPGEN]) == tg, bar);
            __builtin_amdgcn_fence(__ATOMIC_ACQUIRE, "agent");
            xb_add(&bar[XB_XGEN(b.x)], 1u);
            asm volatile("s_waitcnt vmcnt(0)" ::: "memory");
        } else {
            XB_SPIN(xb_ld(&bar[XB_XGEN(b.x)]) == gen, bar);
            __builtin_amdgcn_fence(__ATOMIC_ACQUIRE, "agent");
            asm volatile("s_waitcnt vmcnt(0)" ::: "memory");
        }
    }
    __syncthreads();
}

#define LB_CLS(k)   (2 * (k))
#define LB_SUB(j)   (64 + 64 * (j))
#define LB_GEN(j)   (1088 + 64 * (j))
__device__ __forceinline__ void xcd_local_barrier(unsigned* lb, unsigned* gbar, unsigned x, unsigned nloc) {
    asm volatile("s_waitcnt vmcnt(0)" ::: "memory");
    __syncthreads();
    if (threadIdx.x == 0) {
        __builtin_amdgcn_s_waitcnt(0);
        const unsigned old = xb_add(&lb[LB_SUB(x)], 1u);
        const unsigned gen = old / nloc;
        if (old + 1u == (gen + 1u) * nloc) xb_add(&lb[LB_GEN(x)], 1u);
        else XB_SPIN(xb_ld(&lb[LB_GEN(x)]) == gen, gbar);
        __builtin_amdgcn_fence(__ATOMIC_ACQUIRE, "agent");
        asm volatile("s_waitcnt vmcnt(0)" ::: "memory");
    }
    __syncthreads();
}

constexpr size_t MiB = 1u << 20;
constexpr size_t WS_SS1 = 0, WS_SSP2 = 1 * MiB, WS_SSP3 = 5 * MiB, WS_BAR = 9 * MiB, WS_LBAR = WS_BAR + 16384, WS_CNT = WS_LBAR + 16384, BAR_BYTES = 32768 + 256 * 256;
constexpr size_t WS_W13_1 = 16 * MiB, WS_W2_1 = 27 * MiB, WS_WIN = 33 * MiB, WS_WA = 42 * MiB, WS_WB = 43 * MiB, WS_WOUT = 44 * MiB, WS_W13_2 = 46 * MiB, WS_W2_2 = 57 * MiB;
constexpr size_t WS_XB = 64 * MiB;
constexpr size_t WS_BIG = 192 * MiB;
constexpr size_t WS_OB = WS_BIG + (size_t)M_TOK * IN_W * 2;
constexpr size_t WS_END = WS_OB + (size_t)M_TOK * D_MODEL * 2;
constexpr int LDS_BYTES = 147456, LDS_BARST_OFF = 140000;

struct Args {
    const float* x; const float* norm_ffn1; const float* ffn1_w1; const float* ffn1_w3; const float* ffn1_w2; const float* norm_mix; const float* w_in;
    const float* swa_sinks; const float* rel_bias; const float* w_branch_swa; const float* w_branch_sb; const float* w_out; const float* norm_ffn2;
    const float* ffn2_w1; const float* ffn2_w3; const float* ffn2_w2; const float* norm_final; float* out; unsigned char* ws;
};

__device__ __forceinline__ float wave_sum(float v) {
#pragma unroll
    for (int o = 1; o < 64; o <<= 1) v += __shfl_xor(v, o);
    return v;
}
__device__ __forceinline__ void p0_item(const float* W, int N, int k0, int n0, const float* gain, bf16_t* WT, int K, int drow0, LAS float* scr, int lane) {
    float wv[32];
#pragma unroll
    for (int i = 0; i < 32; ++i) { const int kk = 2 * i + (lane >> 5); wv[i] = W[(size_t)(k0 + kk) * N + n0 + (lane & 31)]; }
    if (gain) {
#pragma unroll
        for (int i = 0; i < 32; ++i) wv[i] *= gain[k0 + 2 * i + (lane >> 5)];
    }
#pragma unroll
    for (int i = 0; i < 32; ++i) { const int kk = 2 * i + (lane >> 5); scr[kk * 33 + (lane & 31)] = wv[i]; }
    asm volatile("s_waitcnt lgkmcnt(0)" ::: "memory");
    const int c = lane & 7;
#pragma unroll
    for (int j = 0; j < 4; ++j) { const int n = (lane >> 3) + 8 * j; const LAS float* s = scr + (8 * c) * 33 + n;
        u32x4 o; o.x = cvt_pk_bf16(s[0 * 33], s[1 * 33]); o.y = cvt_pk_bf16(s[2 * 33], s[3 * 33]); o.z = cvt_pk_bf16(s[4 * 33], s[5 * 33]); o.w = cvt_pk_bf16(s[6 * 33], s[7 * 33]);
        *(u32x4*)(WT + (size_t)(drow0 + n) * K + k0 + 8 * c) = o; }
    asm volatile("s_waitcnt lgkmcnt(0)" ::: "memory");
}
__device__ __forceinline__ bool p0_mat(int& r, const float* W, int K, int N, const float* gain, bf16_t* WT, int mode, LAS float* scr, int lane) {
    const int nblk = N / 32, items = (K / 64) * nblk;
    if (r >= items) { r -= items; return false; }
    const int kb = r / nblk, nb = r % nblk, n0 = 32 * nb;
    const int drow0 = mode == 0 ? n0 : ((n0 >> 7) * 256 + (n0 & 127) + (mode == 2 ? 128 : 0));
    p0_item(W, N, 64 * kb, n0, gain, WT, K, drow0, scr, lane);
    return true;
}

__global__ void __launch_bounds__(512, 2) mk_fwd(Args a) {
    extern __shared__ __attribute__((aligned(16))) unsigned char lds_raw[];
    LAS unsigned char* lds = (LAS unsigned char*)lds_raw;
    cg::grid_group grid = cg::this_grid();
    const int tid = threadIdx.x, lane = tid & 63, wave = __builtin_amdgcn_readfirstlane(tid >> 6);
    const int G = gridDim.x, bx = blockIdx.x;
    const int vcu = (G % 8 == 0) ? (bx % 8) * (G / 8) + bx / 8 : bx;
    unsigned char* ws = a.ws;
    float* ss1 = (float*)(ws + WS_SS1); float* ssp2 = (float*)(ws + WS_SSP2); float* ssp3 = (float*)(ws + WS_SSP3);
    bf16_t* W13_1 = (bf16_t*)(ws + WS_W13_1); bf16_t* W2_1 = (bf16_t*)(ws + WS_W2_1); bf16_t* WIN = (bf16_t*)(ws + WS_WIN); bf16_t* WA = (bf16_t*)(ws + WS_WA);
    bf16_t* WB = (bf16_t*)(ws + WS_WB); bf16_t* WOUT = (bf16_t*)(ws + WS_WOUT); bf16_t* W13_2 = (bf16_t*)(ws + WS_W13_2); bf16_t* W2_2 = (bf16_t*)(ws + WS_W2_2);
    bf16_t* XB = (bf16_t*)(ws + WS_XB); bf16_t* U = (bf16_t*)(ws + WS_BIG); bf16_t* PJ = (bf16_t*)(ws + WS_BIG); bf16_t* OB = (bf16_t*)(ws + WS_OB);
    const int gw = vcu * 8 + wave, NGW = G * 8;
    if (tid < 2) ((volatile LAS unsigned*)(lds + LDS_BARST_OFF))[tid] = 0u;
    __syncthreads();
    const XcdBarrier xbar = xcd_barrier_post((unsigned*)(ws + WS_BAR), (volatile LAS unsigned*)(lds + LDS_BARST_OFF));
    unsigned* lbar = (unsigned*)(ws + WS_LBAR);
    if (tid == 0) (void)__hip_atomic_fetch_or(&lbar[LB_CLS(bx & 7)], 1u << xbar.x, __ATOMIC_RELAXED, __HIP_MEMORY_SCOPE_AGENT);

    {
        LAS float* scr = (LAS float*)(lds + wave * 16384);
        constexpr int NITEMS = 4 * 1408 + 2 * 1408 + 2176 + 256 + 256 + 512;
        for (int it = gw; it < NITEMS; it += NGW) {
            int r = it;
            if (p0_mat(r, a.ffn1_w1, D_MODEL, D_FF, a.norm_ffn1, W13_1, 1, scr, lane)) continue;
            if (p0_mat(r, a.ffn1_w3, D_MODEL, D_FF, a.norm_ffn1, W13_1, 2, scr, lane)) continue;
            if (p0_mat(r, a.ffn1_w2, D_FF, D_MODEL, nullptr, W2_1, 0, scr, lane)) continue;
            if (p0_mat(r, a.w_in, D_MODEL, IN_W, a.norm_mix, WIN, 0, scr, lane)) continue;
            if (p0_mat(r, a.w_branch_swa, 512, D_MODEL, nullptr, WA, 0, scr, lane)) continue;
            if (p0_mat(r, a.w_branch_sb, 512, D_MODEL, nullptr, WB, 0, scr, lane)) continue;
            if (p0_mat(r, a.w_out, D_MODEL, D_MODEL, nullptr, WOUT, 0, scr, lane)) continue;
            if (p0_mat(r, a.ffn2_w1, D_MODEL, D_FF, a.norm_ffn2, W13_2, 1, scr, lane)) continue;
            if (p0_mat(r, a.ffn2_w3, D_MODEL, D_FF, a.norm_ffn2, W13_2, 2, scr, lane)) continue;
            p0_mat(r, a.ffn2_w2, D_FF, D_MODEL, nullptr, W2_2, 0, scr, lane);
        }
        for (int m = gw; m < M_TOK; m += 4 * NGW) {
            f32x4 v[4][4];
#pragma unroll
            for (int q = 0; q < 4; ++q) { const f32x4* xr = (const f32x4*)(a.x + (size_t)(m + q * NGW) * D_MODEL) + lane;
#pragma unroll
                for (int j = 0; j < 4; ++j) v[q][j] = xr[64 * j]; }
#pragma unroll
            for (int q = 0; q < 4; ++q) { float s = 0.f;
#pragma unroll
                for (int j = 0; j < 4; ++j) s += (v[q][j][0] * v[q][j][0] + v[q][j][1] * v[q][j][1]) + (v[q][j][2] * v[q][j][2] + v[q][j][3] * v[q][j][3]);
                s = wave_sum(s);
                u32x2* o8 = (u32x2*)(XB + (size_t)(m + q * NGW) * D_MODEL) + lane;
#pragma unroll
                for (int j = 0; j < 4; ++j) { u32x2 w; w.x = cvt_pk_bf16(v[q][j][0], v[q][j][1]); w.y = cvt_pk_bf16(v[q][j][2], v[q][j][3]); o8[64 * j] = w; }
                if (lane == 0) ss1[m + q * NGW] = s; }
        }
    }
    if (a.ws == nullptr) grid.sync();
    xcd_barrier(xbar);
    int loc = ((G & 7) == 0 && G >= 8) ? 1 : 0;
    { unsigned all = 0u;
#pragma unroll
      for (int k = 0; k < 8; ++k) { const unsigned mk = (unsigned)__builtin_amdgcn_readfirstlane(xb_ld(&lbar[LB_CLS(k)])); if (mk == 0u || (mk & (mk - 1u)) != 0u || (all & mk) != 0u) loc = 0; all |= mk; } }
    const unsigned nloc_l = (unsigned)(G >> 3);
#define SEAM() do { if (loc) xcd_local_barrier(lbar, (unsigned*)(ws + WS_BAR), (unsigned)(bx & 7), nloc_l); else xcd_barrier(xbar); } while (0)
    pg8::StaticOrder S;
    { pg8::Gemm g{XB, W13_1, M_TOK, 2 * D_FF, D_MODEL, D_MODEL}; S.init(M_TOK, 2 * D_FF, G, bx); pg8::EpiSwiglu<1> E{U, ss1}; pg8::gemm_phase(lds, g, S, E); }
    SEAM();
    { pg8::Gemm g{U, W2_1, M_TOK, D_MODEL, D_FF, U_PITCH, U_SLAB * 2}; S.init(M_TOK, D_MODEL, G, bx, 1); pg8::EpiResid<false, false> E{nullptr, a.out, XB, ssp2, 0.5f}; pg8::gemm_phase(lds, g, S, E); }
    SEAM();
    { pg8::Gemm g{XB, WIN, M_TOK, IN_W, D_MODEL, D_MODEL}; S.init(M_TOK, IN_W, G, bx); pg8::EpiProj E{PJ, ssp2}; pg8::gemm_phase(lds, g, S, E); }
    SEAM();
    swa_phase(lds, PJ, OB, a.swa_sinks, a.rel_bias, G, vcu, loc);
    sb_phase(lds, PJ, OB, G, vcu, loc);
    SEAM();
    { pg8::Gemm g{OB, WA, M_TOK, D_MODEL, 512, D_MODEL}; S.init(M_TOK, D_MODEL, G, bx); pg8::EpiGate<false> E{PJ + C_GA, PJ + C_GA}; pg8::gemm_phase(lds, g, S, E); }
    { pg8::Gemm g{OB + 512, WB, M_TOK, D_MODEL, 512, D_MODEL}; S.init(M_TOK, D_MODEL, G, bx); pg8::EpiGate<true> E{PJ + C_GB, PJ + C_GA}; pg8::gemm_phase(lds, g, S, E); }
    SEAM();
    { pg8::Gemm g{PJ + C_GA, WOUT, M_TOK, D_MODEL, D_MODEL, PITCH}; S.init(M_TOK, D_MODEL, G, bx, 1);   pg8::EpiResid<false, false> E{nullptr, a.out, XB, ssp3, 1.0f}; pg8::gemm_phase(lds, g, S, E); }
    SEAM();
    { pg8::Gemm g{XB, W13_2, M_TOK, 2 * D_FF, D_MODEL, D_MODEL}; S.init(M_TOK, 2 * D_FF, G, bx); pg8::EpiSwiglu<16> E{U, ssp3}; pg8::gemm_phase(lds, g, S, E); }
    SEAM();
    if (loc && G == 256) {
        pg8::Gemm g{U, W2_2, M_TOK, D_MODEL, D_FF, U_PITCH, U_SLAB * 2}; S.init(M_TOK, D_MODEL, G, bx, 1); pg8::EpiFinalLocal E{XB, a.out, ssp2, (unsigned*)(ws + WS_CNT), a.norm_final, 0.5f}; pg8::gemm_phase(lds, g, S, E);
    } else {
    { pg8::Gemm g{U, W2_2, M_TOK, D_MODEL, D_FF, U_PITCH, U_SLAB * 2}; S.init(M_TOK, D_MODEL, G, bx, 1); pg8::EpiResid<false, false> E{nullptr, a.out, XB, ssp2, 0.5f}; pg8::gemm_phase(lds, g, S, E); }
    SEAM();
    {
        const f32x4* gp = (const f32x4*)a.norm_final + 2 * lane; f32x4 gv[2][2];
#pragma unroll
        for (int j = 0; j < 2; ++j) { gv[j][0] = gp[128 * j]; gv[j][1] = gp[128 * j + 1]; }
        const int rstep = (loc && NGW == 2048) ? 256 : NGW, rbase = (loc && NGW == 2048) ? (gw >> 8) * 8192 + (gw & 255) : gw;
        for (int k = 0; rbase + k * rstep < M_TOK && k < (M_TOK + NGW - 1) / NGW; k += 2) {
            const int m = rbase + k * rstep;
            u32x4 v[2][2]; float ps[2];
#pragma unroll
            for (int q = 0; q < 2; ++q) { const size_t row = (size_t)(m + q * rstep); const u32x4* xr = (const u32x4*)(XB + row * D_MODEL) + lane;
                v[q][0] = xr[0]; v[q][1] = xr[64]; ps[q] = ssp2[row * 16 + (lane & 15)]; }
#pragma unroll
            for (int q = 0; q < 2; ++q) {
                float s = ps[q]; s += __shfl_xor(s, 1); s += __shfl_xor(s, 2); s += __shfl_xor(s, 4); s += __shfl_xor(s, 8);
                const float rs = __builtin_amdgcn_rsqf(s * (1.0f / D_MODEL) + RMS_EPS);
                f32x4* orow = (f32x4*)(a.out + (size_t)(m + q * rstep) * D_MODEL) + 2 * lane;
#pragma unroll
                for (int j = 0; j < 2; ++j) { const u32x4 w = v[q][j];
                    const f32x4 o0 = (f32x4){bf_lo(w.x), bf_hi(w.x), bf_lo(w.y), bf_hi(w.y)} * rs * gv[j][0], o1 = (f32x4){bf_lo(w.z), bf_hi(w.z), bf_lo(w.w), bf_hi(w.w)} * rs * gv[j][1];
                    orow[128 * j] = o0; orow[128 * j + 1] = o1; }
            }
        }
    }
    }
}

extern "C" void kernel_launch(void* const* d_in, const int* in_sizes, int n_in, void* d_out, int out_size, void* d_ws, size_t ws_size, hipStream_t stream) {
    static int grid = 0;
    if (grid == 0) {
        if (n_in != 17 || in_sizes[0] != M_TOK * D_MODEL || out_size != M_TOK * D_MODEL || ws_size < WS_END) {
            fprintf(stderr, "kernel_launch: unexpected shapes: n_in %d in0 %d out %d ws %zu (need %zu)\n", n_in, n_in > 0 ? in_sizes[0] : -1, out_size, ws_size, (size_t)WS_END); grid = -1; return; }
        int dev = 0, cus = 0, per_cu = 0;
        hipGetDevice(&dev); hipDeviceGetAttribute(&cus, hipDeviceAttributeMultiprocessorCount, dev);
        if (hipFuncSetAttribute((const void*)mk_fwd, hipFuncAttributeMaxDynamicSharedMemorySize, LDS_BYTES) != hipSuccess) { fprintf(stderr, "kernel_launch: hipFuncSetAttribute failed\n"); grid = -1; return; }
        if (hipOccupancyMaxActiveBlocksPerMultiprocessor(&per_cu, (const void*)mk_fwd, 512, LDS_BYTES) != hipSuccess || per_cu < 1) { fprintf(stderr, "kernel_launch: occupancy query says %d\n", per_cu); per_cu = 1; }
        (void)hipGetLastError();
        grid = cus;
    }
    if (grid < 0) return;
    Args a{};
    a.x = (const float*)d_in[0]; a.norm_ffn1 = (const float*)d_in[1]; a.ffn1_w1 = (const float*)d_in[2]; a.ffn1_w3 = (const float*)d_in[3]; a.ffn1_w2 = (const float*)d_in[4];
    a.norm_mix = (const float*)d_in[5]; a.w_in = (const float*)d_in[6]; a.swa_sinks = (const float*)d_in[7]; a.rel_bias = (const float*)d_in[8];
    a.w_branch_swa = (const float*)d_in[9]; a.w_branch_sb = (const float*)d_in[10]; a.w_out = (const float*)d_in[11]; a.norm_ffn2 = (const float*)d_in[12];
    a.ffn2_w1 = (const float*)d_in[13]; a.ffn2_w3 = (const float*)d_in[14]; a.ffn2_w2 = (const float*)d_in[15]; a.norm_final = (const float*)d_in[16];
    a.out = (float*)d_out; a.ws = (unsigned char*)d_ws;
    if (hipMemsetAsync((char*)d_ws + WS_BAR, 0, BAR_BYTES, stream) != hipSuccess) { fprintf(stderr, "kernel_launch: memset failed\n"); return; }
    void* args[] = {&a};
    hipError_t e = hipLaunchCooperativeKernel((const void*)mk_fwd, dim3(grid), dim3(512), args, LDS_BYTES, stream);
    if (e != hipSuccess) fprintf(stderr, "kernel_launch: cooperative launch failed: %s (grid %d)\n", hipGetErrorString(e), grid);
}
```

```cpp
#include <hip/hip_runtime.h>
#include <hip/hip_cooperative_groups.h>
#include <cstdio>
#include <cstdint>
namespace cg = cooperative_groups;

#define LAS __attribute__((address_space(3)))
typedef unsigned short bf16_t;
typedef short bf16x8 __attribute__((ext_vector_type(8)));
typedef float f32x4 __attribute__((ext_vector_type(4)));
typedef unsigned u32x4 __attribute__((ext_vector_type(4)));
typedef unsigned u32x2 __attribute__((ext_vector_type(2)));
typedef float f32x2 __attribute__((ext_vector_type(2)));

constexpr int D_MODEL = 1024, BATCH = 8, SEQ = 8192, M_TOK = BATCH * SEQ, D_FF = 2816, IN_W = 4352;
constexpr float RMS_EPS = 1e-6f;
constexpr int U_PITCH = 2880;
constexpr size_t U_SLAB = (size_t)SEQ * IN_W;
constexpr int PITCH = IN_W;
constexpr int C_QA = 0, C_KA = 512, C_VA = 640, C_QB = 768, C_KB = 1280, C_VB = 1792, C_GA = 2304, C_GB = 3328;

__device__ __forceinline__ unsigned cvt_pk_bf16(float lo, float hi) { unsigned r; asm volatile("v_cvt_pk_bf16_f32 %0, %1, %2" : "=v"(r) : "v"(lo), "v"(hi)); return r; }
__device__ __forceinline__ float bf_lo(unsigned w) { return __uint_as_float(w << 16); }
__device__ __forceinline__ float bf_hi(unsigned w) { return __uint_as_float(w & 0xffff0000u); }
__device__ __forceinline__ float fast_rcp(float x) { return __builtin_amdgcn_rcpf(x); }
__device__ __forceinline__ float fast_exp(float x) { return __builtin_amdgcn_exp2f(x * 1.44269504089f); }
__device__ __forceinline__ float fast_log(float x) { return __builtin_amdgcn_logf(x) * 0.69314718056f; }
__device__ __forceinline__ float sigmoidf_(float v) { return fast_rcp(1.0f + fast_exp(-v)); }

namespace pg8 {
constexpr int BM = 256, BK = 64, HALF = 128, HTB = HALF * BK * 2, STAGE_BYTES = 8 * HTB, NXCD = 8, WGM = 8;
__host__ __device__ __forceinline__ int lds_byte(int r, int c) { const int st = (r >> 4) * 2 + (c >> 5), rr = r & 15, cc = c & 31, ob = rr * 64 + cc * 2; return st * 1024 + (ob ^ (((ob >> 9) & 1) << 5)); }
__host__ __device__ __forceinline__ void stage_rc(int b, int& R, int& C) { const int st = b / 1024, sb = b % 1024, swz = sb ^ (((sb >> 9) & 1) << 5); R = (st >> 1) * 16 + swz / 64; C = (st & 1) * 32 + (swz % 64) / 2; }
__host__ __device__ __forceinline__ int perm32(int rho) { const int n = rho >> 4, i = rho & 15; return 8 * (i >> 2) + 4 * n + (i & 3); }

#ifndef RB
#define RB 4
#endif
struct Unit { int pm, pn; };
struct Gemm { const bf16_t* A; const bf16_t* Bt; int M, N, K, lda; size_t aslab = 0; };

struct StaticOrder {
    int nM, nN, nwg, G, c, rev;
    __device__ void init(int M, int N, int G_, int c_, int rev_ = 0) { nM = M / BM; nN = N / BM; nwg = nM * nN; G = G_; c = c_; rev = rev_; }
    __device__ bool next(int i, Unit& u) const {
        if ((long)i * G + c >= nwg) return false;
        const long L = (long)(rev ? (nwg / G - 1 - i) : i) * G + c;
        int wgid = (int)L; { const int q = nwg / NXCD, r = nwg % NXCD, xcd = wgid % NXCD, off = wgid / NXCD; wgid = (xcd < r ? xcd * (q + 1) : r * (q + 1) + (xcd - r) * q) + off; }
        const int nig = WGM * nN, gid = wgid / nig, fm = gid * WGM, gsz = (nM - fm) < WGM ? (nM - fm) : WGM;
        u.pm = fm + ((wgid % nig) % gsz); u.pn = (wgid % nig) / gsz; return true;
    }
};

template <int NP> __device__ __forceinline__ void load_rs(const float* ssp, int row0, int fq, float (&rs)[2][4]) {
    if (NP == 1) {
#pragma unroll
        for (int ai = 0; ai < 2; ++ai)
#pragma unroll
            for (int m = 0; m < 4; ++m) rs[ai][m] = ssp[row0 + ai * HALF + m * 16];
    } else {
        f32x4 p[2][4];
#pragma unroll
        for (int ai = 0; ai < 2; ++ai)
#pragma unroll
            for (int m = 0; m < 4; ++m) p[ai][m] = *(const f32x4*)(ssp + (size_t)(row0 + ai * HALF + m * 16) * 16 + 4 * fq);
#pragma unroll
        for (int ai = 0; ai < 2; ++ai)
#pragma unroll
            for (int m = 0; m < 4; ++m) { float s = (p[ai][m][0] + p[ai][m][1]) + (p[ai][m][2] + p[ai][m][3]); s += __shfl_xor(s, 16); s += __shfl_xor(s, 32); rs[ai][m] = s; }
    }
#pragma unroll
    for (int ai = 0; ai < 2; ++ai)
#pragma unroll
        for (int m = 0; m < 4; ++m) rs[ai][m] = __builtin_amdgcn_rsqf(rs[ai][m] * (1.0f / D_MODEL) + RMS_EPS);
}

template <int NP> struct EpiSwiglu {
    static constexpr bool PERM = true;
    bf16_t* U; const float* ssp;
    __device__ __forceinline__ void operator()(const f32x4 (&acc)[2][2][4][2], const Unit& u, int wr, int wc, int fr, int fq) const {
        const int row0 = u.pm * BM + wr * 64 + fr, col0 = u.pn * HALF + wc * 32 + 8 * fq;
        float rs[2][4]; load_rs<NP>(ssp, row0, fq, rs);
#pragma unroll
        for (int ai = 0; ai < 2; ++ai)
#pragma unroll
            for (int m = 0; m < 4; ++m) {
                const int row = row0 + ai * HALF + m * 16; const float r = rs[ai][m];
                const float nrl = r * -1.44269504089f, r2 = r * r;
                unsigned pk[4];
#pragma unroll
                for (int q = 0; q < 4; ++q) {
                    const f32x4 ga = acc[ai][0][m][q >> 1], ua = acc[ai][1][m][q >> 1]; const int e0 = 2 * (q & 1);
                    const f32x2 g = (f32x2){ga[e0], ga[e0 + 1]}, up = (f32x2){ua[e0], ua[e0 + 1]};
                    const f32x2 t = g * nrl; f32x2 ex; ex.x = __builtin_amdgcn_exp2f(t.x); ex.y = __builtin_amdgcn_exp2f(t.y);
                    const f32x2 d = ex + 1.0f; f32x2 rc; rc.x = __builtin_amdgcn_rcpf(d.x); rc.y = __builtin_amdgcn_rcpf(d.y);
                    const f32x2 o = (g * up) * (rc * r2);
                    pk[q] = cvt_pk_bf16(o.x, o.y);
                }
                u32x4 w; w.x = pk[0]; w.y = pk[1]; w.z = pk[2]; w.w = pk[3];
                *(u32x4*)(U + (size_t)(row >> 13) * U_SLAB + (size_t)(row & (SEQ - 1)) * U_PITCH + col0) = w;
            }
    }
};
struct EpiProj {
    static constexpr bool PERM = true;
    bf16_t* P; const float* ssp;
    template <bool GATE> __device__ __forceinline__ void body(const f32x4 (&acc)[2][2][4][2], const Unit& u, int wr, int wc, int fr, int fq) const {
        const int row0 = u.pm * BM + wr * 64 + fr, col0 = u.pn * BM + wc * 32 + 8 * fq;
        float rs[2][4]; load_rs<16>(ssp, row0, fq, rs);
#pragma unroll
        for (int ai = 0; ai < 2; ++ai)
#pragma unroll
            for (int m = 0; m < 4; ++m) {
                const int row = row0 + ai * HALF + m * 16; const float r = rs[ai][m], nrl = r * -1.44269504089f;
#pragma unroll
                for (int bj = 0; bj < 2; ++bj) {
                    unsigned pk[4];
#pragma unroll
                    for (int q = 0; q < 4; ++q) {
                        const f32x4 va = acc[ai][bj][m][q >> 1]; const int e0 = 2 * (q & 1);
                        const f32x2 v = (f32x2){va[e0], va[e0 + 1]};
                        f32x2 o;
                        if (GATE) { const f32x2 t = v * nrl; f32x2 ex; ex.x = __builtin_amdgcn_exp2f(t.x); ex.y = __builtin_amdgcn_exp2f(t.y);
                            const f32x2 d = ex + 1.0f; o.x = __builtin_amdgcn_rcpf(d.x); o.y = __builtin_amdgcn_rcpf(d.y); }
                        else o = v * r;
                        pk[q] = cvt_pk_bf16(o.x, o.y);
                    }
                    u32x4 w; w.x = pk[0]; w.y = pk[1]; w.z = pk[2]; w.w = pk[3];
                    *(u32x4*)(P + (size_t)row * PITCH + col0 + bj * HALF) = w;
                }
            }
    }
    __device__ __forceinline__ void operator()(const f32x4 (&acc)[2][2][4][2], const Unit& u, int wr, int wc, int fr, int fq) const {
        if (u.pn >= 9) body<true>(acc, u, wr, wc, fr, fq); else body<false>(acc, u, wr, wc, fr, fq);
    }
};
template <bool ADD> struct EpiGate {
    static constexpr bool PERM = true;
    const bf16_t* SG; bf16_t* MO;
    __device__ __forceinline__ void operator()(const f32x4 (&acc)[2][2][4][2], const Unit& u, int wr, int wc, int fr, int fq) const {
        const int row0 = u.pm * BM + wr * 64 + fr, col0 = u.pn * BM + wc * 32 + 8 * fq;
#pragma unroll
        for (int ai = 0; ai < 2; ++ai) {
            u32x4 sg[4][2], pr[4][2];
#pragma unroll
            for (int m = 0; m < 4; ++m)
#pragma unroll
                for (int bj = 0; bj < 2; ++bj) { const size_t roff = (size_t)(row0 + ai * HALF + m * 16) * PITCH + col0 + bj * HALF;
                    sg[m][bj] = *(const u32x4*)(SG + roff); if (ADD) pr[m][bj] = *(const u32x4*)(MO + roff); else pr[m][bj] = (u32x4){0u, 0u, 0u, 0u}; }
            asm volatile("" ::: "memory");
#pragma unroll
            for (int m = 0; m < 4; ++m)
#pragma unroll
                for (int bj = 0; bj < 2; ++bj) {
                    const size_t roff = (size_t)(row0 + ai * HALF + m * 16) * PITCH + col0 + bj * HALF;
                    float o[8];
#pragma unroll
                    for (int q = 0; q < 4; ++q) {
                        const f32x4 a = acc[ai][bj][m][q >> 1]; const int e = 2 * (q & 1);
                        o[2 * q] = bf_lo(sg[m][bj][q]) * a[e] + (ADD ? bf_lo(pr[m][bj][q]) : 0.f);
                        o[2 * q + 1] = bf_hi(sg[m][bj][q]) * a[e + 1] + (ADD ? bf_hi(pr[m][bj][q]) : 0.f);
                    }
                    u32x4 w; w.x = cvt_pk_bf16(o[0], o[1]); w.y = cvt_pk_bf16(o[2], o[3]); w.z = cvt_pk_bf16(o[4], o[5]); w.w = cvt_pk_bf16(o[6], o[7]);
                    *(u32x4*)(MO + roff) = w;
                }
        }
    }
};
template <bool BASE_F32, bool OUT_F32> struct EpiResid {
    static constexpr bool PERM = true;
    const float* basef; float* out; bf16_t* xb; float* ssp; float alpha;
    __device__ __forceinline__ void operator()(const f32x4 (&acc)[2][2][4][2], const Unit& u, int wr, int wc, int fr, int fq) const {
        const int row0 = u.pm * BM + wr * 64 + fr, col0 = u.pn * BM + wc * 32 + 8 * fq;
#pragma unroll
        for (int ai = 0; ai < 2; ++ai)
#pragma unroll
        for (int mh = 0; mh < 4; mh += RB) {
            f32x4 bf[BASE_F32 ? RB : 1][2][2]; u32x4 bb[BASE_F32 ? 1 : RB][2];
#pragma unroll
            for (int mm = 0; mm < RB; ++mm) { const size_t off = (size_t)(row0 + ai * HALF + (mh + mm) * 16) * D_MODEL + col0;
#pragma unroll
                for (int bj = 0; bj < 2; ++bj) {
                    if (BASE_F32) { bf[mm][bj][0] = *(const f32x4*)(basef + off + bj * HALF); bf[mm][bj][1] = *(const f32x4*)(basef + off + bj * HALF + 4); }
                    else bb[mm][bj] = *(const u32x4*)(xb + off + bj * HALF);
                } }
            asm volatile("" ::: "memory");
#pragma unroll
            for (int mm = 0; mm < RB; ++mm) {
                const int m = mh + mm;
                const int row = row0 + ai * HALF + m * 16; const size_t off = (size_t)row * D_MODEL + col0; float s = 0.f;
#pragma unroll
                for (int bj = 0; bj < 2; ++bj) {
                    f32x4 b0, b1;
                    if (BASE_F32) { b0 = bf[mm][bj][0]; b1 = bf[mm][bj][1]; }
                    else { const u32x4 w = bb[mm][bj]; b0 = (f32x4){bf_lo(w.x), bf_hi(w.x), bf_lo(w.y), bf_hi(w.y)}; b1 = (f32x4){bf_lo(w.z), bf_hi(w.z), bf_lo(w.w), bf_hi(w.w)}; }
                    const f32x4 o0 = b0 + acc[ai][bj][m][0] * alpha, o1 = b1 + acc[ai][bj][m][1] * alpha;
                    if (OUT_F32) { *(f32x4*)(out + off + bj * HALF) = o0; *(f32x4*)(out + off + bj * HALF + 4) = o1; }
                    else { u32x4 w; w.x = cvt_pk_bf16(o0[0], o0[1]); w.y = cvt_pk_bf16(o0[2], o0[3]); w.z = cvt_pk_bf16(o1[0], o1[1]); w.w = cvt_pk_bf16(o1[2], o1[3]); *(u32x4*)(xb + off + bj * HALF) = w; }
                    s += ((o0[0] * o0[0] + o0[1] * o0[1]) + (o0[2] * o0[2] + o0[3] * o0[3])) + ((o1[0] * o1[0] + o1[1] * o1[1]) + (o1[2] * o1[2] + o1[3] * o1[3]));
                }
                if (ssp) { s += __shfl_xor(s, 16); s += __shfl_xor(s, 32); if (fq == 0) ssp[(size_t)row * 16 + u.pn * 4 + wc] = s; }
            }
            asm volatile("" ::: "memory");
        }
    }
};

struct EpiFinalLocal {
    static constexpr bool PERM = true;
    const bf16_t* xb; float* out; float* ssp; unsigned* cnt; const float* gain; float alpha;
    __device__ __forceinline__ void operator()(const f32x4 (&acc)[2][2][4][2], const Unit& u, int wr, int wc, int fr, int fq) const {
        const int row0 = u.pm * BM + wr * 64 + fr, col0 = u.pn * BM + wc * 32 + 8 * fq;
        f32x4 o[2][4][2][2];
#pragma unroll
        for (int ai = 0; ai < 2; ++ai) {
            u32x4 bb[4][2];
#pragma unroll
            for (int m = 0; m < 4; ++m)
#pragma unroll
                for (int bj = 0; bj < 2; ++bj) bb[m][bj] = *(const u32x4*)(xb + (size_t)(row0 + ai * HALF + m * 16) * D_MODEL + col0 + bj * HALF);
#pragma unroll
            for (int m = 0; m < 4; ++m) { float s = 0.f;
#pragma unroll
                for (int bj = 0; bj < 2; ++bj) { const u32x4 w = bb[m][bj];
                    const f32x4 o0 = (f32x4){bf_lo(w.x), bf_hi(w.x), bf_lo(w.y), bf_hi(w.y)} + acc[ai][bj][m][0] * alpha, o1 = (f32x4){bf_lo(w.z), bf_hi(w.z), bf_lo(w.w), bf_hi(w.w)} + acc[ai][bj][m][1] * alpha;
                    o[ai][m][bj][0] = o0; o[ai][m][bj][1] = o1;
                    s += ((o0[0] * o0[0] + o0[1] * o0[1]) + (o0[2] * o0[2] + o0[3] * o0[3])) + ((o1[0] * o1[0] + o1[1] * o1[1]) + (o1[2] * o1[2] + o1[3] * o1[3])); }
                s += __shfl_xor(s, 16); s += __shfl_xor(s, 32);
                if (fq == 0) ssp[(size_t)(row0 + ai * HALF + m * 16) * 16 + u.pn * 4 + wc] = s; }
        }
        asm volatile("s_waitcnt vmcnt(0)" ::: "memory");
        __builtin_amdgcn_s_barrier();
        if (__builtin_amdgcn_readfirstlane(threadIdx.x >> 6) == 0) {
            if ((threadIdx.x & 63) == 0) {
                unsigned* c = cnt + 64 * u.pm;
                (void)__hip_atomic_fetch_add(c, 1u, __ATOMIC_RELAXED, __HIP_MEMORY_SCOPE_AGENT);
                unsigned sp = 0;
                while (__hip_atomic_load(c, __ATOMIC_RELAXED, __HIP_MEMORY_SCOPE_AGENT) < 4u) { __builtin_amdgcn_s_sleep(1); if (++sp > (1u << 22)) break; }
                __builtin_amdgcn_fence(__ATOMIC_ACQUIRE, "agent");
            }
            asm volatile("s_waitcnt vmcnt(0)" ::: "memory");
        }
        __builtin_amdgcn_s_barrier(); asm volatile("" ::: "memory");
        float rs[2][4];
        { f32x4 p[2][4];
#pragma unroll
          for (int ai = 0; ai < 2; ++ai)
#pragma unroll
            for (int m = 0; m < 4; ++m) p[ai][m] = *(const volatile f32x4*)(ssp + (size_t)(row0 + ai * HALF + m * 16) * 16 + 4 * fq);
#pragma unroll
          for (int ai = 0; ai < 2; ++ai)
#pragma unroll
            for (int m = 0; m < 4; ++m) { float s = (p[ai][m][0] + p[ai][m][1]) + (p[ai][m][2] + p[ai][m][3]); s += __shfl_xor(s, 16); s += __shfl_xor(s, 32); rs[ai][m] = __builtin_amdgcn_rsqf(s * (1.0f / D_MODEL) + RMS_EPS); } }
        f32x4 gv[2][2];
#pragma unroll
        for (int bj = 0; bj < 2; ++bj) { gv[bj][0] = *(const f32x4*)(gain + col0 + bj * HALF); gv[bj][1] = *(const f32x4*)(gain + col0 + bj * HALF + 4); }
#pragma unroll
        for (int ai = 0; ai < 2; ++ai)
#pragma unroll
            for (int m = 0; m < 4; ++m) { const size_t off = (size_t)(row0 + ai * HALF + m * 16) * D_MODEL + col0; const float r = rs[ai][m];
#pragma unroll
                for (int bj = 0; bj < 2; ++bj) { *(f32x4*)(out + off + bj * HALF) = o[ai][m][bj][0] * r * gv[bj][0]; *(f32x4*)(out + off + bj * HALF + 4) = o[ai][m][bj][1] * r * gv[bj][1]; } }
    }
};

template <class Epi>
__device__ __forceinline__ void gemm_phase(LAS unsigned char* lds, const Gemm g, const StaticOrder& S, const Epi& E) {
    int tid = threadIdx.x; asm volatile("" : "+v"(tid));
    const int wid = __builtin_amdgcn_readfirstlane(tid >> 6), lane = tid & 63, wr = wid >> 2, wc = wid & 3, fr = lane & 15, fq = lane >> 4;
    const int K = g.K, nt = K / BK, lda = g.lda;
    unsigned voffA[2], voffB[2];
#pragma unroll
    for (int i = 0; i < 2; ++i) { int R, C; stage_rc(tid * 16 + i * 8192, R, C); const int Rb = Epi::PERM ? ((R & ~31) + perm32(R & 31)) : R;
        voffA[i] = (unsigned)(R * lda + C) * 2u; voffB[i] = (unsigned)(Rb * K + C) * 2u; }
    const size_t kstep = (size_t)(BK * 2);
    const size_t hstepA = (size_t)HALF * lda * 2, hstepB = (size_t)HALF * K * 2;
    const size_t tstepA = 2 * hstepA, tstepB = 2 * hstepB;
    const unsigned ldsw = (unsigned)wid * 1024u;
    const int aoff = lds_byte(wr * 64 + fr, fq * 8), boff = lds_byte(wc * 32 + fr, fq * 8);
#define PG8_SA(b, h) (((b) * 2 + (h)) * HTB)
#define PG8_SB(b, h) ((4 + (b) * 2 + (h)) * HTB)
#define PG8_STAGE(bufoff, gbase, voff) do { _Pragma("unroll") for (int _i = 0; _i < 2; ++_i) \
        __builtin_amdgcn_global_load_lds((const unsigned*)((const char*)(gbase) + (voff)[_i]), (LAS unsigned*)(lds + (bufoff) + ldsw + _i * 8192), 16, 0, 0); } while (0)
#define PG8_LDA(dst, b, h) do { _Pragma("unroll") for (int m = 0; m < 4; ++m) _Pragma("unroll") for (int k = 0; k < 2; ++k) dst[m][k] = *(const LAS bf16x8*)(lds + PG8_SA(b, h) + aoff + m * 2048 + k * 1024); } while (0)
#define PG8_LDB(dst, b, h) do { _Pragma("unroll") for (int n = 0; n < 2; ++n) _Pragma("unroll") for (int k = 0; k < 2; ++k) dst[n][k] = *(const LAS bf16x8*)(lds + PG8_SB(b, h) + boff + n * 2048 + k * 1024); } while (0)
#define PG8_MMA(ai, bj, At, Bt) do { __builtin_amdgcn_s_setprio(1); _Pragma("unroll") for (int m = 0; m < 4; ++m) _Pragma("unroll") for (int n = 0; n < 2; ++n) _Pragma("unroll") for (int k = 0; k < 2; ++k) \
        acc[ai][bj][m][n] = __builtin_amdgcn_mfma_f32_16x16x32_bf16(Bt[n][k], At[m][k], acc[ai][bj][m][n], 0, 0, 0); __builtin_amdgcn_s_setprio(0); } while (0)
#define PG8_WAIT_V(n) asm volatile("s_waitcnt vmcnt(" #n ")" ::: "memory")
#define PG8_WAIT_L(n) asm volatile("s_waitcnt lgkmcnt(" #n ")" ::: "memory")
#define PG8_BAR __builtin_amdgcn_s_barrier()
#define PG8_SCHED __builtin_amdgcn_sched_barrier(0)
    Unit cur, nxt; int ui = 0;
    if (!S.next(0, cur)) return;
    f32x4 acc[2][2][4][2];
#pragma unroll
    for (int a = 0; a < 2; ++a)
#pragma unroll
        for (int b = 0; b < 2; ++b)
#pragma unroll
            for (int m = 0; m < 4; ++m)
#pragma unroll
                for (int n = 0; n < 2; ++n) acc[a][b][m][n] = (f32x4){0.f, 0.f, 0.f, 0.f};
    bf16x8 At[4][2], B0[2][2], B1[2][2];
    const size_t aslab = g.aslab ? g.aslab : 32 * tstepA;
    const char* cA = (const char*)g.A + (size_t)(cur.pm >> 5) * aslab + (size_t)(cur.pm & 31) * tstepA; const char* cB = (const char*)g.Bt + (size_t)cur.pn * tstepB;
    PG8_STAGE(PG8_SB(0, 0), cB, voffB); PG8_STAGE(PG8_SB(0, 1), cB + hstepB, voffB); PG8_STAGE(PG8_SA(0, 0), cA, voffA); PG8_STAGE(PG8_SA(0, 1), cA + hstepA, voffA);
    if (wr == 1) PG8_BAR;
    PG8_WAIT_V(2); PG8_BAR;
    PG8_STAGE(PG8_SB(1, 0), cB + kstep, voffB); PG8_STAGE(PG8_SA(1, 0), cA + kstep, voffA); PG8_STAGE(PG8_SB(1, 1), cB + hstepB + kstep, voffB);
    PG8_WAIT_V(6); PG8_BAR;
    for (;;) {
        const bool has_next = S.next(ui + 1, nxt);
        const char* nA = has_next ? (const char*)g.A + (size_t)(nxt.pm >> 5) * aslab + (size_t)(nxt.pm & 31) * tstepA : cA; const char* nB = has_next ? (const char*)g.Bt + (size_t)nxt.pn * tstepB : cB;
        for (int t = 0; t < nt; t += 2) {
            const bool last = (t == nt - 2);
            const char* a1 = cA + (size_t)(t + 1) * kstep;
            const char* a2 = last ? nA : cA + (size_t)(t + 2) * kstep; const char* b2 = last ? nB : cB + (size_t)(t + 2) * kstep;
            const char* a3 = a2 + kstep; const char* b3 = b2 + kstep;
            PG8_LDB(B0, 0, 0); PG8_LDB(B1, 0, 1); PG8_SCHED; PG8_LDA(At, 0, 0); PG8_STAGE(PG8_SA(1, 1), a1 + hstepA, voffA);
            PG8_WAIT_V(8); PG8_WAIT_L(0); PG8_BAR; PG8_MMA(0, 0, At, B0); PG8_MMA(0, 1, At, B1); PG8_BAR; PG8_SCHED;
            PG8_LDA(At, 0, 1); PG8_STAGE(PG8_SB(0, 0), b2, voffB); PG8_STAGE(PG8_SB(0, 1), b2 + hstepB, voffB); PG8_STAGE(PG8_SA(0, 0), a2, voffA);
            PG8_WAIT_V(8); PG8_WAIT_L(0); PG8_BAR; PG8_MMA(1, 0, At, B0); PG8_MMA(1, 1, At, B1); PG8_BAR; PG8_SCHED;
            PG8_LDB(B0, 1, 0); PG8_LDB(B1, 1, 1); PG8_SCHED; PG8_LDA(At, 1, 0); PG8_STAGE(PG8_SA(0, 1), a2 + hstepA, voffA);
            PG8_WAIT_V(8); PG8_WAIT_L(0); PG8_BAR; PG8_MMA(0, 0, At, B0); PG8_MMA(0, 1, At, B1); PG8_BAR; PG8_SCHED;
            PG8_LDA(At, 1, 1); PG8_STAGE(PG8_SB(1, 0), b3, voffB); PG8_STAGE(PG8_SB(1, 1), b3 + hstepB, voffB); PG8_STAGE(PG8_SA(1, 0), a3, voffA);
            PG8_WAIT_V(8); PG8_WAIT_L(0); PG8_BAR; PG8_MMA(1, 0, At, B0); PG8_MMA(1, 1, At, B1); PG8_BAR; PG8_SCHED;
        }
        if (wr == 0) PG8_BAR;
        E(acc, cur, wr, wc, fr, fq);
        if (!has_next) break;
#pragma unroll
        for (int a = 0; a < 2; ++a)
#pragma unroll
            for (int b = 0; b < 2; ++b)
#pragma unroll
                for (int m = 0; m < 4; ++m)
#pragma unroll
                    for (int n = 0; n < 2; ++n) acc[a][b][m][n] = (f32x4){0.f, 0.f, 0.f, 0.f};
        cur = nxt; cA = nA; cB = nB; ++ui;
        if (wr == 1) PG8_BAR;
    }
    PG8_WAIT_V(0);
    PG8_BAR;
#undef PG8_SA
#undef PG8_SB
#undef PG8_STAGE
#undef PG8_LDA
#undef PG8_LDB
#undef PG8_MMA
#undef PG8_WAIT_V
#undef PG8_WAIT_L
#undef PG8_BAR
#undef PG8_SCHED
}
}

__device__ __forceinline__ int kpos(int key) { return (key & ~31) | (((key >> 2) & 3) << 3) | (((key >> 4) & 1) << 2) | (key & 3); }
__device__ __forceinline__ f32x4 mfma16(bf16x8 a, bf16x8 b, f32x4 c) { return __builtin_amdgcn_mfma_f32_16x16x32_bf16(a, b, c, 0, 0, 0); }
__device__ __forceinline__ int t5_bucket(int d) {
    if (d < 16) return d;
    int b = 16;
    b += d >= 19; b += d >= 21; b += d >= 24; b += d >= 27; b += d >= 31; b += d >= 35; b += d >= 40; b += d >= 46;
    b += d >= 52; b += d >= 59; b += d >= 67; b += d >= 77; b += d >= 87; b += d >= 99; b += d >= 113;
    return b;
}

constexpr int AP = 80;
__device__ __forceinline__ void tr16(unsigned addr, u32x2 (&v)[16]) {
    asm volatile(
        "ds_read_b64_tr_b16 %0, %16 offset:0\n\tds_read_b64_tr_b16 %1, %16 offset:2560\n\tds_read_b64_tr_b16 %2, %16 offset:32\n\tds_read_b64_tr_b16 %3, %16 offset:2592\n\t"
        "ds_read_b64_tr_b16 %4, %16 offset:64\n\tds_read_b64_tr_b16 %5, %16 offset:2624\n\tds_read_b64_tr_b16 %6, %16 offset:96\n\tds_read_b64_tr_b16 %7, %16 offset:2656\n\t"
        "ds_read_b64_tr_b16 %8, %16 offset:5120\n\tds_read_b64_tr_b16 %9, %16 offset:7680\n\tds_read_b64_tr_b16 %10, %16 offset:5152\n\tds_read_b64_tr_b16 %11, %16 offset:7712\n\t"
        "ds_read_b64_tr_b16 %12, %16 offset:5184\n\tds_read_b64_tr_b16 %13, %16 offset:7744\n\tds_read_b64_tr_b16 %14, %16 offset:5216\n\tds_read_b64_tr_b16 %15, %16 offset:7776\n\t"
        "s_waitcnt lgkmcnt(0)"
        : "=&v"(v[0]), "=&v"(v[1]), "=&v"(v[2]), "=&v"(v[3]), "=&v"(v[4]), "=&v"(v[5]), "=&v"(v[6]), "=&v"(v[7]),
          "=&v"(v[8]), "=&v"(v[9]), "=&v"(v[10]), "=&v"(v[11]), "=&v"(v[12]), "=&v"(v[13]), "=&v"(v[14]), "=&v"(v[15])
        : "v"(addr) : "memory");
}
__device__ __forceinline__ bf16x8 vfrag(const u32x2 (&v)[16], int jj, int dt) {
    u32x4 w; w.x = v[(jj * 4 + dt) * 2].x; w.y = v[(jj * 4 + dt) * 2].y; w.z = v[(jj * 4 + dt) * 2 + 1].x; w.w = v[(jj * 4 + dt) * 2 + 1].y; return __builtin_bit_cast(bf16x8, w);
}
__device__ __forceinline__ bf16x8 pfrag(const float (&a)[4][4], int jj) {
    u32x4 pw; pw.x = cvt_pk_bf16(a[2 * jj][0], a[2 * jj][1]); pw.y = cvt_pk_bf16(a[2 * jj][2], a[2 * jj][3]);
    pw.z = cvt_pk_bf16(a[2 * jj + 1][0], a[2 * jj + 1][1]); pw.w = cvt_pk_bf16(a[2 * jj + 1][2], a[2 * jj + 1][3]); return __builtin_bit_cast(bf16x8, pw);
}

__device__ __forceinline__ void tr8(unsigned addr, u32x2 (&v)[8]) {
    asm volatile(
        "ds_read_b64_tr_b16 %0, %8 offset:0\n\tds_read_b64_tr_b16 %1, %8 offset:2560\n\tds_read_b64_tr_b16 %2, %8 offset:32\n\tds_read_b64_tr_b16 %3, %8 offset:2592\n\t"
        "ds_read_b64_tr_b16 %4, %8 offset:64\n\tds_read_b64_tr_b16 %5, %8 offset:2624\n\tds_read_b64_tr_b16 %6, %8 offset:96\n\tds_read_b64_tr_b16 %7, %8 offset:2656\n\t"
        "s_waitcnt lgkmcnt(0)"
        : "=&v"(v[0]), "=&v"(v[1]), "=&v"(v[2]), "=&v"(v[3]), "=&v"(v[4]), "=&v"(v[5]), "=&v"(v[6]), "=&v"(v[7])
        : "v"(addr) : "memory");
}
constexpr int SWA_V_OFF = 256 * AP * 2, SWA_BT_OFF = SWA_V_OFF + 272 * AP * 2;
struct SwaUnit { int hk, n, b; };
__device__ __forceinline__ SwaUnit swa_unit(int ui) { SwaUnit u; u.hk = ui & 1; u.n = (ui >> 1) & 63; u.b = ui >> 7; return u; }
__device__ __forceinline__ void swa_fetch(const bf16_t* P, const SwaUnit& u, int tid, u32x4 (&kr)[4], u32x4 (&vr)[4]) {
    const size_t tokp = (size_t)u.b * SEQ + 128 * u.n - 128;
#pragma unroll
    for (int i = 0; i < 4; ++i) {
        const int c = tid + 512 * i, key = c >> 3, dp = c & 7;
        kr[i] = (u32x4){0u, 0u, 0u, 0u}; vr[i] = (u32x4){0u, 0u, 0u, 0u};
        if (u.n > 0 || key >= 128) { const bf16_t* src = P + (tokp + key) * PITCH + C_KA + 64 * u.hk + 8 * dp; kr[i] = *(const u32x4*)src; vr[i] = *(const u32x4*)(src + (C_VA - C_KA)); }
    }
}
__device__ __forceinline__ int unit_remap(int ui, int G, int NU, int loc) { if (!loc) return ui; const int L = G >> 3, i = ui / G, c = ui - i * G; return (c / L) * (NU >> 3) + (c % L) + L * i; }
__device__ __forceinline__ void swa_phase(LAS unsigned char* lds, const bf16_t* P, bf16_t* OB, const float* sinks, const float* rel_bias, int G, int cu, int loc) {
    int tid = threadIdx.x; asm volatile("" : "+v"(tid));
    const int lane = tid & 63, w = __builtin_amdgcn_readfirstlane(tid >> 6), fr = lane & 15, fq = lane >> 4;
    LAS bf16_t* Ks = (LAS bf16_t*)lds; LAS bf16_t* Vs = (LAS bf16_t*)(lds + SWA_V_OFF); LAS float* bt = (LAS float*)(lds + SWA_BT_OFF);
    const unsigned vlane = (unsigned)(size_t)(lds + SWA_V_OFF) + (unsigned)((16 * w + 4 * fq + (fr >> 2)) * (AP * 2) + 8 * (fr & 3));
    for (int t = tid; t < 1024; t += 512) { const int h = t >> 7, d = t & 127; bt[t] = rel_bias[t5_bucket(d) * 8 + h]; }
    for (int t = tid; t < 16 * AP / 2; t += 512) ((LAS unsigned*)(Vs + 256 * AP))[t] = 0u;
    constexpr int NU = BATCH * 64 * 2;
    u32x4 kr[4], vr[4];
    if (cu < NU) swa_fetch(P, swa_unit(unit_remap(cu, G, NU, loc)), tid, kr, vr);
    const int qi = 16 * w + fr;
    for (int ui = cu; ui < NU; ui += G) {
        const SwaUnit u = swa_unit(unit_remap(ui, G, NU, loc));
        const size_t qtok = (size_t)u.b * SEQ + 128 * u.n + qi;
        const bf16_t* qp = P + qtok * PITCH + C_QA + 256 * u.hk + 8 * fq;
        bf16x8 q0n = *(const bf16x8*)qp, q1n = *(const bf16x8*)(qp + 32);
        __syncthreads();
#pragma unroll
        for (int i = 0; i < 4; ++i) { const int c = tid + 512 * i, key = c >> 3, dp = c & 7; *(LAS u32x4*)(Ks + key * AP + 8 * dp) = kr[i]; *(LAS u32x4*)(Vs + key * AP + 8 * dp) = vr[i]; }
        __syncthreads();
        if (ui + G < NU) swa_fetch(P, swa_unit(unit_remap(ui + G, G, NU, loc)), tid, kr, vr);
#pragma unroll 1
        for (int g = 0; g < 4; ++g) {
        const int h = 4 * u.hk + g;
        const bf16x8 q0 = q0n, q1 = q1n;
        if (g < 3) { q0n = *(const bf16x8*)(qp + 64 * (g + 1)); q1n = *(const bf16x8*)(qp + 64 * (g + 1) + 32); }
        const float sink = sinks[h];
        float bias[9][4];
#pragma unroll
        for (int j = 0; j < 9; ++j)
#pragma unroll
            for (int r = 0; r < 4; ++r) bias[j][r] = bt[h * 128 + ((128 + fr - 16 * j - 4 * fq - r) & 127)];
        f32x4 S[9];
#pragma unroll
        for (int j = 0; j < 9; ++j) {
            const LAS bf16_t* kp = Ks + (16 * w + 16 * j + fr) * AP + 8 * fq;
            f32x4 s = (f32x4){0.f, 0.f, 0.f, 0.f};
            s = mfma16(*(const LAS bf16x8*)kp, q0, s); s = mfma16(*(const LAS bf16x8*)(kp + 32), q1, s); S[j] = s;
        }
        float mx = sink;
#pragma unroll
        for (int j = 0; j < 9; ++j)
#pragma unroll
            for (int r = 0; r < 4; ++r) {
                float l = S[j][r] * 0.125f + bias[j][r];
                if (j == 0) l = (4 * fq + r > fr) ? l : -1e30f;
                if (j == 8) l = (4 * fq + r <= fr) ? l : -1e30f;
                S[j][r] = l;
            }
        if (u.n == 0) {
#pragma unroll
            for (int j = 0; j < 9; ++j)
#pragma unroll
                for (int r = 0; r < 4; ++r) S[j][r] = (16 * w + 16 * j + 4 * fq + r >= 128) ? S[j][r] : -1e30f;
        }
#pragma unroll
        for (int j = 0; j < 9; ++j) mx = fmaxf(mx, fmaxf(fmaxf(S[j][0], S[j][1]), fmaxf(S[j][2], S[j][3])));
        mx = fmaxf(mx, __shfl_xor(mx, 16)); mx = fmaxf(mx, __shfl_xor(mx, 32));
        const float mxl = mx * 1.44269504089f;
        float sum = 0.f;
        f32x4 O[4];
#pragma unroll
        for (int dt = 0; dt < 4; ++dt) O[dt] = (f32x4){0.f, 0.f, 0.f, 0.f};
#pragma unroll
        for (int cc = 0; cc < 2; ++cc) {
            u32x2 vf[16]; tr16(vlane + (unsigned)(cc * 64 * AP * 2), vf);
            float p[4][4];
#pragma unroll
            for (int j = 0; j < 4; ++j)
#pragma unroll
                for (int r = 0; r < 4; ++r) { p[j][r] = __builtin_amdgcn_exp2f(S[4 * cc + j][r] * 1.44269504089f - mxl); sum += p[j][r]; }
#pragma unroll
            for (int jj = 0; jj < 2; ++jj) { const bf16x8 pf = pfrag(p, jj);
#pragma unroll
                for (int dt = 0; dt < 4; ++dt) O[dt] = mfma16(vfrag(vf, jj, dt), pf, O[dt]); }
        }
        {
            u32x2 vf[8]; tr8(vlane + (unsigned)(128 * AP * 2), vf);
            float p[4];
#pragma unroll
            for (int r = 0; r < 4; ++r) { p[r] = __builtin_amdgcn_exp2f(S[8][r] * 1.44269504089f - mxl); sum += p[r]; }
            u32x4 pw; pw.x = cvt_pk_bf16(p[0], p[1]); pw.y = cvt_pk_bf16(p[2], p[3]); pw.z = 0u; pw.w = 0u;
            const bf16x8 pf = __builtin_bit_cast(bf16x8, pw);
#pragma unroll
            for (int dt = 0; dt < 4; ++dt) { u32x4 wv; wv.x = vf[dt * 2].x; wv.y = vf[dt * 2].y; wv.z = vf[dt * 2 + 1].x; wv.w = vf[dt * 2 + 1].y; O[dt] = mfma16(__builtin_bit_cast(bf16x8, wv), pf, O[dt]); }
        }
        sum += __shfl_xor(sum, 16); sum += __shfl_xor(sum, 32);
        const float inv = 1.0f / (sum + __builtin_amdgcn_exp2f(sink * 1.44269504089f - mxl));
        bf16_t* op = OB + qtok * D_MODEL + 64 * h + 4 * fq;
#pragma unroll
        for (int dt = 0; dt < 4; ++dt) { u32x2 wv; wv.x = cvt_pk_bf16(O[dt][0] * inv, O[dt][1] * inv); wv.y = cvt_pk_bf16(O[dt][2] * inv, O[dt][3] * inv); *(u32x2*)(op + 16 * dt) = wv; }
        }
    }
    __syncthreads();
}

constexpr int SB_PRE = 2, SB_TILES = SB_PRE + 2, SB_KEYS = 64 * SB_TILES, SB_NLD = SB_KEYS / 64;
constexpr int SB_V_OFF = SB_KEYS * AP * 2, SB_FLAG_OFF = 2 * SB_V_OFF;
constexpr float SB_DONE = 1e-30f;
struct SbUnit { int h, qt, b; };
__device__ __forceinline__ SbUnit sb_unit(int ui) { SbUnit u; u.h = ui & 7; u.qt = (ui >> 3) & 63; u.b = ui >> 9; return u; }
__device__ __forceinline__ void sb_fetch(const bf16_t* P, const SbUnit& u, int tid, u32x4 (&kr)[SB_NLD], u32x4 (&vr)[SB_NLD]) {
    const int k0 = 128 * u.qt - 64 * SB_PRE;
#pragma unroll
    for (int i = 0; i < SB_NLD; ++i) {
        const int c = tid + 512 * i, key = c >> 3, dp = c & 7;
        kr[i] = (u32x4){0u, 0u, 0u, 0u}; vr[i] = (u32x4){0u, 0u, 0u, 0u};
        if (k0 + key >= 0) { const bf16_t* src = P + ((size_t)u.b * SEQ + k0 + key) * PITCH + C_KB + 64 * u.h + 8 * dp; kr[i] = *(const u32x4*)src; vr[i] = *(const u32x4*)(src + (C_VB - C_KB)); }
    }
}
template <bool DIAG>
__device__ __forceinline__ void sb_step(const LAS bf16_t* Kt, unsigned vaddr, int kbase, int qpos, bf16x8 q0, bf16x8 q1, float& carry, f32x4 (&O)[4], int fr, int fq) {
    f32x4 s[2];
#pragma unroll
    for (int j = 0; j < 2; ++j) {
        const LAS bf16_t* kp = Kt + (16 * j + fr) * AP + 8 * fq;
        f32x4 t = (f32x4){0.f, 0.f, 0.f, 0.f};
        t = mfma16(*(const LAS bf16x8*)kp, q0, t); t = mfma16(*(const LAS bf16x8*)(kp + 32), q1, t); s[j] = t;
    }
    u32x2 vf[8]; tr8(vaddr, vf);
    f32x2 sg[4], om[4];
#pragma unroll
    for (int r = 0; r < 4; ++r) {
        f32x2 t = (f32x2){s[0][r], s[1][r]} * (-0.125f * 1.44269504089f);
        t.x = __builtin_amdgcn_fmed3f(t.x, -115.4f, 115.4f); t.y = __builtin_amdgcn_fmed3f(t.y, -115.4f, 115.4f);
        f32x2 ex; ex.x = __builtin_amdgcn_exp2f(t.x); ex.y = __builtin_amdgcn_exp2f(t.y);
        const f32x2 d = ex + 1.0f; f32x2 rc; rc.x = __builtin_amdgcn_rcpf(d.x); rc.y = __builtin_amdgcn_rcpf(d.y);
        f32x2 o = ex * rc;
        if (DIAG) { const int key = kbase + 4 * fq + r; const bool c0 = key < qpos, c1 = key + 16 < qpos;
            rc.x = c0 ? rc.x : 0.f; o.x = c0 ? o.x : 1.f; rc.y = c1 ? rc.y : 0.f; o.y = c1 ? o.y : 1.f; }
        sg[r] = rc; om[r] = o;
    }
    const f32x2 g = (om[0] * om[1]) * (om[2] * om[3]);
    f32x2 x1; x1.x = __shfl_xor(g.x, 16); x1.y = __shfl_xor(g.y, 16);
    const f32x2 p1 = g * x1;
    f32x2 x2; x2.x = __shfl_xor(p1.x, 32); x2.y = __shfl_xor(p1.y, 32);
    const f32x2 T = p1 * x2;
    const f32x2 one = (f32x2){1.0f, 1.0f};
    const f32x2 hi = fq == 0 ? (x1 * x2) : (fq == 1 ? x2 : (fq == 2 ? x1 : one));
    f32x2 accv; accv.y = carry * hi.y; accv.x = carry * T.y * hi.x;
    float a_[2][4];
#pragma unroll
    for (int r = 3; r >= 0; --r) { const f32x2 a = sg[r] * accv; accv = accv * om[r]; a_[0][r] = a.x; a_[1][r] = a.y; }
    carry = carry * T.y * T.x;
    u32x4 pw; pw.x = cvt_pk_bf16(a_[0][0], a_[0][1]); pw.y = cvt_pk_bf16(a_[0][2], a_[0][3]); pw.z = cvt_pk_bf16(a_[1][0], a_[1][1]); pw.w = cvt_pk_bf16(a_[1][2], a_[1][3]);
    const bf16x8 pf = __builtin_bit_cast(bf16x8, pw);
#pragma unroll
    for (int dt = 0; dt < 4; ++dt) { u32x4 wv; wv.x = vf[dt * 2].x; wv.y = vf[dt * 2].y; wv.z = vf[dt * 2 + 1].x; wv.w = vf[dt * 2 + 1].y; O[dt] = mfma16(__builtin_bit_cast(bf16x8, wv), pf, O[dt]); }
}
__device__ __forceinline__ void sb_phase(LAS unsigned char* lds, const bf16_t* P, bf16_t* OB, int G, int cu, int loc) {
    int tid = threadIdx.x; asm volatile("" : "+v"(tid));
    const int lane = tid & 63, w = __builtin_amdgcn_readfirstlane(tid >> 6), fr = lane & 15, fq = lane >> 4;
    LAS bf16_t* Ks = (LAS bf16_t*)lds; LAS bf16_t* Vs = (LAS bf16_t*)(lds + SB_V_OFF); volatile LAS int* flags = (volatile LAS int*)(lds + SB_FLAG_OFF);
    const unsigned vlane = (unsigned)(size_t)(lds + SB_V_OFF) + (unsigned)((4 * fq + (fr >> 2)) * (AP * 2) + 8 * (fr & 3));
    constexpr int NU = BATCH * 64 * 8;
    u32x4 kr[SB_NLD], vr[SB_NLD];
    bf16x8 q0n = (bf16x8){0, 0, 0, 0, 0, 0, 0, 0}, q1n = q0n;
    if (cu < NU) { const SbUnit u0 = sb_unit(unit_remap(cu, G, NU, loc)); sb_fetch(P, u0, tid, kr, vr);
        const bf16_t* qp0 = P + ((size_t)u0.b * SEQ + 128 * u0.qt + 16 * w + fr) * PITCH + C_QB + 64 * u0.h + 8 * fq; q0n = *(const bf16x8*)qp0; q1n = *(const bf16x8*)(qp0 + 32); }
    int fbit = 0;
    __syncthreads();
    for (int ui = cu; ui < NU; ui += G) {
        const SbUnit u = sb_unit(unit_remap(ui, G, NU, loc));
        const size_t tokb = (size_t)u.b * SEQ;
        const int qpos = 128 * u.qt + 16 * w + fr, qmax = 128 * u.qt + 16 * w + 15;
        const bf16x8 q0 = q0n, q1 = q1n;
#pragma unroll
        for (int i = 0; i < SB_NLD; ++i) { const int c = tid + 512 * i, key = c >> 3, dp = c & 7; *(LAS u32x4*)(Ks + key * AP + 8 * dp) = kr[i]; *(LAS u32x4*)(Vs + key * AP + 8 * dp) = vr[i]; }
        __syncthreads();
        if (ui + G < NU) { const SbUnit un = sb_unit(unit_remap(ui + G, G, NU, loc)); sb_fetch(P, un, tid, kr, vr);
            const bf16_t* qpn = P + ((size_t)un.b * SEQ + 128 * un.qt + 16 * w + fr) * PITCH + C_QB + 64 * un.h + 8 * fq; q0n = *(const bf16x8*)qpn; q1n = *(const bf16x8*)(qpn + 32); }
        float carry = 1.0f; bool done = false;
        f32x4 O[4];
#pragma unroll
        for (int dt = 0; dt < 4; ++dt) O[dt] = (f32x4){0.f, 0.f, 0.f, 0.f};
        const int kt0 = 2 * u.qt - SB_PRE, kt_lo = kt0 > 0 ? kt0 : 0;
        const int ks_diag = (128 * u.qt + 16 * w) >> 5;
#pragma unroll 1
        for (int ks = (qmax - 1) >> 5; ks >= 2 * kt_lo && !done; --ks) {
            const int row = 32 * ks - 64 * kt0;
            if (ks >= ks_diag) sb_step<true>(Ks + row * AP, vlane + (unsigned)(row * AP * 2), 32 * ks, qpos, q0, q1, carry, O, fr, fq);
            else sb_step<false>(Ks + row * AP, vlane + (unsigned)(row * AP * 2), 32 * ks, qpos, q0, q1, carry, O, fr, fq);
            done = __all(carry < SB_DONE) != 0;
        }
        if (lane == 0) flags[w] = (!done && kt_lo > 0) ? 1 : 0;
        __syncthreads();
        const int more = flags[0] | flags[1] | flags[2] | flags[3] | flags[4] | flags[5] | flags[6] | flags[7];
        if (more) {
#pragma unroll 1
            for (int kt = kt_lo - 1; kt >= 0; --kt) {
                volatile LAS int* fl = flags + 8 + 8 * fbit; fbit ^= 1;
                if (lane == 0) fl[w] = done ? 1 : 0;
                __syncthreads();
                const int all = fl[0] & fl[1] & fl[2] & fl[3] & fl[4] & fl[5] & fl[6] & fl[7];
                if (all) break;
                { const int key = tid >> 3, dp = tid & 7;
                  const bf16_t* src = P + (tokb + 64 * kt + key) * PITCH + C_KB + 64 * u.h + 8 * dp;
                  const u32x4 kv = *(const u32x4*)src, vv = *(const u32x4*)(src + (C_VB - C_KB));
                  *(LAS u32x4*)(Ks + key * AP + 8 * dp) = kv; *(LAS u32x4*)(Vs + key * AP + 8 * dp) = vv; }
                __syncthreads();
                if (!done) { sb_step<false>(Ks + 32 * AP, vlane + (unsigned)(32 * AP * 2), 64 * kt + 32, qpos, q0, q1, carry, O, fr, fq); done = __all(carry < SB_DONE) != 0; }
                if (!done) { sb_step<false>(Ks, vlane, 64 * kt, qpos, q0, q1, carry, O, fr, fq); done = __all(carry < SB_DONE) != 0; }
            }
            __syncthreads();
        }
        bf16_t* op = OB + (tokb + qpos) * D_MODEL + 512 + 64 * u.h + 4 * fq;
#pragma unroll
        for (int dt = 0; dt < 4; ++dt) { u32x2 wv; wv.x = cvt_pk_bf16(O[dt][0], O[dt][1]); wv.y = cvt_pk_bf16(O[dt][2], O[dt][3]); *(u32x2*)(op + 16 * dt) = wv; }
    }
    __syncthreads();
}

#define XB_TMO      128
#define XB_XCNT(j)  (256  + 64 * (j))
#define XB_XSUB(j)  (1280 + 64 * (j))
#define XB_XGEN(j)  (2304 + 64 * (j))
#define XB_TOP      3328
#define XB_TOPGEN   3392
#define XCD_BAR_WORDS 3456
#define XB_SPIN_CAP (1u << 20)
__device__ __forceinline__ unsigned xb_ld(unsigned* p)              { return __hip_atomic_load(p, __ATOMIC_RELAXED, __HIP_MEMORY_SCOPE_AGENT); }
__device__ __forceinline__ unsigned xb_add(unsigned* p, unsigned v) { return __hip_atomic_fetch_add(p, v, __ATOMIC_RELAXED, __HIP_MEMORY_SCOPE_AGENT); }
__device__ __forceinline__ unsigned xb_xcc_id() { return (unsigned)__builtin_amdgcn_s_getreg((3 << 11) | 20) & 0xFu; }
#define XB_SPIN(cond, bar) do { unsigned _sp = 0; while (cond) { __builtin_amdgcn_s_sleep(1); \
    if ((++_sp & 255u) == 0u) { if (xb_ld(&(bar)[XB_TMO])) break; if (_sp > XB_SPIN_CAP) { atomicAdd(&(bar)[XB_TMO], 1u); break; } } } } while (0)
struct XcdBarrier { unsigned* bar; unsigned x; volatile LAS unsigned* st; };
__device__ __forceinline__ XcdBarrier xcd_barrier_post(unsigned* bar, volatile LAS unsigned* st) {
    XcdBarrier b; b.bar = bar; b.x = xb_xcc_id(); b.st = st;
    if (threadIdx.x == 0) (void)xb_add(&bar[XB_XCNT(b.x)], 1u);
    return b;
}
__device__ __forceinline__ void xcd_barrier_complete(unsigned* bar, unsigned x, unsigned& nloc, unsigned& nx) {
    const unsigned G = gridDim.x * gridDim.y * gridDim.z;
    unsigned sum, cnt, mine, sp = 0u;
    for (;;) {
        sum = 0u; cnt = 0u; mine = 0u;
#pragma unroll
        for (unsigned j = 0; j < 16; ++j) { const unsigned c = xb_ld(&bar[XB_XCNT(j)]); sum += c; cnt += (c > 0u) ? 1u : 0u; mine = (j == x) ? c : mine; }
        if (sum == G) break;
        __builtin_amdgcn_s_sleep(1);
        if ((++sp & 255u) == 0u) { if (xb_ld(&bar[XB_TMO])) break; if (sp > XB_SPIN_CAP) { atomicAdd(&bar[XB_TMO], 1u); break; } }
    }
    nloc = mine > 0u ? mine : 1u; nx = cnt > 0u ? cnt : 1u;
}
__device__ __forceinline__ void xcd_barrier(const XcdBarrier& b) {
    asm volatile("s_waitcnt vmcnt(0)" ::: "memory");
    __syncthreads();
    if (threadIdx.x == 0) {
        unsigned* bar = b.bar;
        __builtin_amdgcn_s_waitcnt(0);
        unsigned nloc = b.st[0], nx = b.st[1];
        if (nloc == 0u) { xcd_barrier_complete(bar, b.x, nloc, nx); b.st[0] = nloc; b.st[1] = nx; }
        const unsigned old = xb_add(&bar[XB_XSUB(b.x)], 1u);
        const unsigned gen = old / nloc;
        if (old + 1u == (gen + 1u) * nloc) {
            __builtin_amdgcn_fence(__ATOMIC_RELEASE, "agent");
            asm volatile("s_waitcnt vmcnt(0)" ::: "memory");
            const unsigned og = xb_add(&bar[XB_TOP], 1u);
            const unsigned tg = og / nx;
            if (og + 1u == (tg + 1u) * nx) xb_add(&bar[XB_TOPGEN], 1u);
            else XB_SPIN(xb_ld(&bar[XB_TOPGEN]) == tg, bar);
            __builtin_amdgcn_fence(__ATOMIC_ACQUIRE, "agent");
            xb_add(&bar[XB_XGEN(b.x)], 1u);
            asm volatile("s_waitcnt vmcnt(0)" ::: "memory");
        } else {
            XB_SPIN(xb_ld(&bar[XB_XGEN(b.x)]) == gen, bar);
            __builtin_amdgcn_fence(__ATOMIC_ACQUIRE, "agent");
            asm volatile("s_waitcnt vmcnt(0)" ::: "memory");
        }
    }
    __syncthreads();
}

#define LB_CLS(k)   (2 * (k))
#define LB_SUB(j)   (64 + 64 * (j))
#define LB_GEN(j)   (1088 + 64 * (j))
__device__ __forceinline__ void xcd_local_barrier(unsigned* lb, unsigned* gbar, unsigned x, unsigned nloc) {
    asm volatile("s_waitcnt vmcnt(0)" ::: "memory");
    __syncthreads();
    if (threadIdx.x == 0) {
        __builtin_amdgcn_s_waitcnt(0);
        const unsigned old = xb_add(&lb[LB_SUB(x)], 1u);
        const unsigned gen = old / nloc;
        if (old + 1u == (gen + 1u) * nloc) xb_add(&lb[LB_GEN(x)], 1u);
        else XB_SPIN(xb_ld(&lb[LB_GEN(x)]) == gen, gbar);
        __builtin_amdgcn_fence(__ATOMIC_ACQUIRE, "agent");
        asm volatile("s_waitcnt vmcnt(0)" ::: "memory");
    }
    __syncthreads();
}

constexpr size_t MiB = 1u << 20;
constexpr size_t WS_SS1 = 0, WS_SSP2 = 1 * MiB, WS_SSP3 = 5 * MiB, WS_BAR = 9 * MiB, WS_LBAR = WS_BAR + 16384, WS_CNT = WS_LBAR + 16384, BAR_BYTES = 32768 + 256 * 256;
constexpr size_t WS_W13_1 = 16 * MiB, WS_W2_1 = 27 * MiB, WS_WIN = 33 * MiB, WS_WA = 42 * MiB, WS_WB = 43 * MiB, WS_WOUT = 44 * MiB, WS_W13_2 = 46 * MiB, WS_W2_2 = 57 * MiB;
constexpr size_t WS_XB = 64 * MiB;
constexpr size_t WS_BIG = 192 * MiB;
constexpr size_t WS_OB = WS_BIG + (size_t)M_TOK * IN_W * 2;
constexpr size_t WS_END = WS_OB + (size_t)M_TOK * D_MODEL * 2;
constexpr int LDS_BYTES = 147456, LDS_BARST_OFF = 140000;

struct Args {
    const float* x; const float* norm_ffn1; const float* ffn1_w1; const float* ffn1_w3; const float* ffn1_w2; const float* norm_mix; const float* w_in;
    const float* swa_sinks; const float* rel_bias; const float* w_branch_swa; const float* w_branch_sb; const float* w_out; const float* norm_ffn2;
    const float* ffn2_w1; const float* ffn2_w3; const float* ffn2_w2; const float* norm_final; float* out; unsigned char* ws;
};

__device__ __forceinline__ float wave_sum(float v) {
#pragma unroll
    for (int o = 1; o < 64; o <<= 1) v += __shfl_xor(v, o);
    return v;
}
__device__ __forceinline__ void p0_item(const float* W, int N, int k0, int n0, const float* gain, bf16_t* WT, int K, int drow0, LAS float* scr, int lane) {
    float wv[32];
#pragma unroll
    for (int i = 0; i < 32; ++i) { const int kk = 2 * i + (lane >> 5); wv[i] = W[(size_t)(k0 + kk) * N + n0 + (lane & 31)]; }
    if (gain) {
#pragma unroll
        for (int i = 0; i < 32; ++i) wv[i] *= gain[k0 + 2 * i + (lane >> 5)];
    }
#pragma unroll
    for (int i = 0; i < 32; ++i) { const int kk = 2 * i + (lane >> 5); scr[kk * 33 + (lane & 31)] = wv[i]; }
    asm volatile("s_waitcnt lgkmcnt(0)" ::: "memory");
    const int c = lane & 7;
#pragma unroll
    for (int j = 0; j < 4; ++j) { const int n = (lane >> 3) + 8 * j; const LAS float* s = scr + (8 * c) * 33 + n;
        u32x4 o; o.x = cvt_pk_bf16(s[0 * 33], s[1 * 33]); o.y = cvt_pk_bf16(s[2 * 33], s[3 * 33]); o.z = cvt_pk_bf16(s[4 * 33], s[5 * 33]); o.w = cvt_pk_bf16(s[6 * 33], s[7 * 33]);
        *(u32x4*)(WT + (size_t)(drow0 + n) * K + k0 + 8 * c) = o; }
    asm volatile("s_waitcnt lgkmcnt(0)" ::: "memory");
}
__device__ __forceinline__ bool p0_mat(int& r, const float* W, int K, int N, const float* gain, bf16_t* WT, int mode, LAS float* scr, int lane) {
    const int nblk = N / 32, items = (K / 64) * nblk;
    if (r >= items) { r -= items; return false; }
    const int kb = r / nblk, nb = r % nblk, n0 = 32 * nb;
    const int drow0 = mode == 0 ? n0 : ((n0 >> 7) * 256 + (n0 & 127) + (mode == 2 ? 128 : 0));
    p0_item(W, N, 64 * kb, n0, gain, WT, K, drow0, scr, lane);
    return true;
}

__global__ void __launch_bounds__(512, 2) mk_fwd(Args a) {
    extern __shared__ __attribute__((aligned(16))) unsigned char lds_raw[];
    LAS unsigned char* lds = (LAS unsigned char*)lds_raw;
    cg::grid_group grid = cg::this_grid();
    const int tid = threadIdx.x, lane = tid & 63, wave = __builtin_amdgcn_readfirstlane(tid >> 6);
    const int G = gridDim.x, bx = blockIdx.x;
    const int vcu = (G % 8 == 0) ? (bx % 8) * (G / 8) + bx / 8 : bx;
    unsigned char* ws = a.ws;
    float* ss1 = (float*)(ws + WS_SS1); float* ssp2 = (float*)(ws + WS_SSP2); float* ssp3 = (float*)(ws + WS_SSP3);
    bf16_t* W13_1 = (bf16_t*)(ws + WS_W13_1); bf16_t* W2_1 = (bf16_t*)(ws + WS_W2_1); bf16_t* WIN = (bf16_t*)(ws + WS_WIN); bf16_t* WA = (bf16_t*)(ws + WS_WA);
    bf16_t* WB = (bf16_t*)(ws + WS_WB); bf16_t* WOUT = (bf16_t*)(ws + WS_WOUT); bf16_t* W13_2 = (bf16_t*)(ws + WS_W13_2); bf16_t* W2_2 = (bf16_t*)(ws + WS_W2_2);
    bf16_t* XB = (bf16_t*)(ws + WS_XB); bf16_t* U = (bf16_t*)(ws + WS_BIG); bf16_t* PJ = (bf16_t*)(ws + WS_BIG); bf16_t* OB = (bf16_t*)(ws + WS_OB);
    const int gw = vcu * 8 + wave, NGW = G * 8;
    if (tid < 2) ((volatile LAS unsigned*)(lds + LDS_BARST_OFF))[tid] = 0u;
    __syncthreads();
    const XcdBarrier xbar = xcd_barrier_post((unsigned*)(ws + WS_BAR), (volatile LAS unsigned*)(lds + LDS_BARST_OFF));
    unsigned* lbar = (unsigned*)(ws + WS_LBAR);
    if (tid == 0) (void)__hip_atomic_fetch_or(&lbar[LB_CLS(bx & 7)], 1u << xbar.x, __ATOMIC_RELAXED, __HIP_MEMORY_SCOPE_AGENT);

    {
        LAS float* scr = (LAS float*)(lds + wave * 16384);
        constexpr int NITEMS = 4 * 1408 + 2 * 1408 + 2176 + 256 + 256 + 512;
        for (int it = gw; it < NITEMS; it += NGW) {
            int r = it;
            if (p0_mat(r, a.ffn1_w1, D_MODEL, D_FF, a.norm_ffn1, W13_1, 1, scr, lane)) continue;
            if (p0_mat(r, a.ffn1_w3, D_MODEL, D_FF, a.norm_ffn1, W13_1, 2, scr, lane)) continue;
            if (p0_mat(r, a.ffn1_w2, D_FF, D_MODEL, nullptr, W2_1, 0, scr, lane)) continue;
            if (p0_mat(r, a.w_in, D_MODEL, IN_W, a.norm_mix, WIN, 0, scr, lane)) continue;
            if (p0_mat(r, a.w_branch_swa, 512, D_MODEL, nullptr, WA, 0, scr, lane)) continue;
            if (p0_mat(r, a.w_branch_sb, 512, D_MODEL, nullptr, WB, 0, scr, lane)) continue;
            if (p0_mat(r, a.w_out, D_MODEL, D_MODEL, nullptr, WOUT, 0, scr, lane)) continue;
            if (p0_mat(r, a.ffn2_w1, D_MODEL, D_FF, a.norm_ffn2, W13_2, 1, scr, lane)) continue;
            if (p0_mat(r, a.ffn2_w3, D_MODEL, D_FF, a.norm_ffn2, W13_2, 2, scr, lane)) continue;
            p0_mat(r, a.ffn2_w2, D_FF, D_MODEL, nullptr, W2_2, 0, scr, lane);
        }
        for (int m = gw; m < M_TOK; m += 4 * NGW) {
            f32x4 v[4][4];
#pragma unroll
            for (int q = 0; q < 4; ++q) { const f32x4* xr = (const f32x4*)(a.x + (size_t)(m + q * NGW) * D_MODEL) + lane;
#pragma unroll
                for (int j = 0; j < 4; ++j) v[q][j] = xr[64 * j]; }
#pragma unroll
            for (int q = 0; q < 4; ++q) { float s = 0.f;
#pragma unroll
                for (int j = 0; j < 4; ++j) s += (v[q][j][0] * v[q][j][0] + v[q][j][1] * v[q][j][1]) + (v[q][j][2] * v[q][j][2] + v[q][j][3] * v[q][j][3]);
                s = wave_sum(s);
                u32x2* o8 = (u32x2*)(XB + (size_t)(m + q * NGW) * D_MODEL) + lane;
#pragma unroll
                for (int j = 0; j < 4; ++j) { u32x2 w; w.x = cvt_pk_bf16(v[q][j][0], v[q][j][1]); w.y = cvt_pk_bf16(v[q][j][2], v[q][j][3]); o8[64 * j] = w; }
                if (lane == 0) ss1[m + q * NGW] = s; }
        }
    }
    if (a.ws == nullptr) grid.sync();
    xcd_barrier(xbar);
    int loc = ((G & 7) == 0 && G >= 8) ? 1 : 0;
    { unsigned all = 0u;
#pragma unroll
      for (int k = 0; k < 8; ++k) { const unsigned mk = (unsigned)__builtin_amdgcn_readfirstlane(xb_ld(&lbar[LB_CLS(k)])); if (mk == 0u || (mk & (mk - 1u)) != 0u || (all & mk) != 0u) loc = 0; all |= mk; } }
    const unsigned nloc_l = (unsigned)(G >> 3);
#define SEAM() do { if (loc) xcd_local_barrier(lbar, (unsigned*)(ws + WS_BAR), (unsigned)(bx & 7), nloc_l); else xcd_barrier(xbar); } while (0)
    pg8::StaticOrder S;
    { pg8::Gemm g{XB, W13_1, M_TOK, 2 * D_FF, D_MODEL, D_MODEL}; S.init(M_TOK, 2 * D_FF, G, bx); pg8::EpiSwiglu<1> E{U, ss1}; pg8::gemm_phase(lds, g, S, E); }
    SEAM();
    { pg8::Gemm g{U, W2_1, M_TOK, D_MODEL, D_FF, U_PITCH, U_SLAB * 2}; S.init(M_TOK, D_MODEL, G, bx, 1); pg8::EpiResid<false, false> E{nullptr, a.out, XB, ssp2, 0.5f}; pg8::gemm_phase(lds, g, S, E); }
    SEAM();
    { pg8::Gemm g{XB, WIN, M_TOK, IN_W, D_MODEL, D_MODEL}; S.init(M_TOK, IN_W, G, bx); pg8::EpiProj E{PJ, ssp2}; pg8::gemm_phase(lds, g, S, E); }
    SEAM();
    swa_phase(lds, PJ, OB, a.swa_sinks, a.rel_bias, G, vcu, loc);
    sb_phase(lds, PJ, OB, G, vcu, loc);
    SEAM();
    { pg8::Gemm g{OB, WA, M_TOK, D_MODEL, 512, D_MODEL}; S.init(M_TOK, D_MODEL, G, bx); pg8::EpiGate<false> E{PJ + C_GA, PJ + C_GA}; pg8::gemm_phase(lds, g, S, E); }
    { pg8::Gemm g{OB + 512, WB, M_TOK, D_MODEL, 512, D_MODEL}; S.init(M_TOK, D_MODEL, G, bx); pg8::EpiGate<true> E{PJ + C_GB, PJ + C_GA}; pg8::gemm_phase(lds, g, S, E); }
    SEAM();
    { pg8::Gemm g{PJ + C_GA, WOUT, M_TOK, D_MODEL, D_MODEL, PITCH}; S.init(M_TOK, D_MODEL, G, bx); pg8::EpiResid<false, false> E{nullptr, a.out, XB, ssp3, 1.0f}; pg8::gemm_phase(lds, g, S, E); }
    SEAM();
    { pg8::Gemm g{XB, W13_2, M_TOK, 2 * D_FF, D_MODEL, D_MODEL}; S.init(M_TOK, 2 * D_FF, G, bx); pg8::EpiSwiglu<16> E{U, ssp3}; pg8::gemm_phase(lds, g, S, E); }
    SEAM();
    if (loc && G == 256) {
        pg8::Gemm g{U, W2_2, M_TOK, D_MODEL, D_FF, U_PITCH, U_SLAB * 2}; S.init(M_TOK, D_MODEL, G, bx, 1); pg8::EpiFinalLocal E{XB, a.out, ssp2, (unsigned*)(ws + WS_CNT), a.norm_final, 0.5f}; pg8::gemm_phase(lds, g, S, E);
    } else {
    { pg8::Gemm g{U, W2_2, M_TOK, D_MODEL, D_FF, U_PITCH, U_SLAB * 2}; S.init(M_TOK, D_MODEL, G, bx, 1); pg8::EpiResid<false, false> E{nullptr, a.out, XB, ssp2, 0.5f}; pg8::gemm_phase(lds, g, S, E); }
    SEAM();
    {
        const f32x4* gp = (const f32x4*)a.norm_final + 2 * lane; f32x4 gv[2][2];
#pragma unroll
        for (int j = 0; j < 2; ++j) { gv[j][0] = gp[128 * j]; gv[j][1] = gp[128 * j + 1]; }
        const int rstep = (loc && NGW == 2048) ? 256 : NGW, rbase = (loc && NGW == 2048) ? (gw >> 8) * 8192 + (gw & 255) : gw;
        for (int k = 0; rbase + k * rstep < M_TOK && k < (M_TOK + NGW - 1) / NGW; k += 2) {
            const int m = rbase + k * rstep;
            u32x4 v[2][2]; float ps[2];
#pragma unroll
            for (int q = 0; q < 2; ++q) { const size_t row = (size_t)(m + q * rstep); const u32x4* xr = (const u32x4*)(XB + row * D_MODEL) + lane;
                v[q][0] = xr[0]; v[q][1] = xr[64]; ps[q] = ssp2[row * 16 + (lane & 15)]; }
#pragma unroll
            for (int q = 0; q < 2; ++q) {
                float s = ps[q]; s += __shfl_xor(s, 1); s += __shfl_xor(s, 2); s += __shfl_xor(s, 4); s += __shfl_xor(s, 8);
                const float rs = __builtin_amdgcn_rsqf(s * (1.0f / D_MODEL) + RMS_EPS);
                f32x4* orow = (f32x4*)(a.out + (size_t)(m + q * rstep) * D_MODEL) + 2 * lane;
#pragma unroll
                for (int j = 0; j < 2; ++j) { const u32x4 w = v[q][j];
                    const f32x4 o0 = (f32x4){bf_lo(w.x), bf_hi(w.x), bf_lo(w.y), bf_hi(w.y)} * rs * gv[j][0], o1 = (f32x4){bf_lo(w.z), bf_hi(w.z), bf_lo(w.w), bf_hi(w.w)} * rs * gv[j][1];
                    orow[128 * j] = o0; orow[128 * j + 1] = o1; }
            }
        }
    }
    }
}

extern "C" void kernel_launch(void* const* d_in, const int* in_sizes, int n_in, void* d_out, int out_size, void* d_ws, size_t ws_size, hipStream_t stream) {
    static int grid = 0;
    if (grid == 0) {
        if (n_in != 17 || in_sizes[0] != M_TOK * D_MODEL || out_size != M_TOK * D_MODEL || ws_size < WS_END) {
            fprintf(stderr, "kernel_launch: unexpected shapes: n_in %d in0 %d out %d ws %zu (need %zu)\n", n_in, n_in > 0 ? in_sizes[0] : -1, out_size, ws_size, (size_t)WS_END); grid = -1; return; }
        int dev = 0, cus = 0, per_cu = 0;
        hipGetDevice(&dev); hipDeviceGetAttribute(&cus, hipDeviceAttributeMultiprocessorCount, dev);
        if (hipFuncSetAttribute((const void*)mk_fwd, hipFuncAttributeMaxDynamicSharedMemorySize, LDS_BYTES) != hipSuccess) { fprintf(stderr, "kernel_launch: hipFuncSetAttribute failed\n"); grid = -1; return; }
        if (hipOccupancyMaxActiveBlocksPerMultiprocessor(&per_cu, (const void*)mk_fwd, 512, LDS_BYTES) != hipSuccess || per_cu < 1) { fprintf(stderr, "kernel_launch: occupancy query says %d\n", per_cu); per_cu = 1; }
        (void)hipGetLastError();
        grid = cus;
    }
    if (grid < 0) return;
    Args a{};
    a.x = (const float*)d_in[0]; a.norm_ffn1 = (const float*)d_in[1]; a.ffn1_w1 = (const float*)d_in[2]; a.ffn1_w3 = (const float*)d_in[3]; a.ffn1_w2 = (const float*)d_in[4];
    a.norm_mix = (const float*)d_in[5]; a.w_in = (const float*)d_in[6]; a.swa_sinks = (const float*)d_in[7]; a.rel_bias = (const float*)d_in[8];
    a.w_branch_swa = (const float*)d_in[9]; a.w_branch_sb = (const float*)d_in[10]; a.w_out = (const float*)d_in[11]; a.norm_ffn2 = (const float*)d_in[12];
    a.ffn2_w1 = (const float*)d_in[13]; a.ffn2_w3 = (const float*)d_in[14]; a.ffn2_w2 = (const float*)d_in[15]; a.norm_final = (const float*)d_in[16];
    a.out = (float*)d_out; a.ws = (unsigned char*)d_ws;
    if (hipMemsetAsync((char*)d_ws + WS_BAR, 0, BAR_BYTES, stream) != hipSuccess) { fprintf(stderr, "kernel_launch: memset failed\n"); return; }
    void* args[] = {&a};
    hipError_t e = hipLaunchCooperativeKernel((const void*)mk_fwd, dim3(grid), dim3(512), args, LDS_BYTES, stream);
    if (e != hipSuccess) fprintf(stderr, "kernel_launch: cooperative launch failed: %s (grid %d)\n", hipGetErrorString(e), grid);
}
```
